# Optimizing an MI355X kernel written in HIP

```python
import jax, jax.numpy as jnp
from jax import lax
import numpy as np

D_MODEL = 1024
BATCH = 4
SEQ = 8192
DEPTH = 1

N_META = 16
HEAD_SIZE_A = 64
N_HEADS_A = D_MODEL // HEAD_SIZE_A
WIDTH_A = N_HEADS_A * HEAD_SIZE_A
DECAY_LORA = 64
AAA_LORA = 64
GATE_LORA = 128
LN_X_EPS = 64e-5
WIDTH_B = D_MODEL
N_BLOCKS_B = 16
BLOCK_B = WIDTH_B // N_BLOCKS_B
CONV_WIDTH = 4
LRU_C = 8.0
D_FF = 4 * D_MODEL
RMS_EPS = 1e-6
RWKV_SPLITS = (WIDTH_A, 2 * WIDTH_A, 3 * WIDTH_A, 3 * WIDTH_A + DECAY_LORA, 3 * WIDTH_A + DECAY_LORA + AAA_LORA)
COLS_A = 3 * WIDTH_A + DECAY_LORA + AAA_LORA + GATE_LORA
N_IN_COLS = COLS_A + 2 * WIDTH_B + 2 * D_MODEL

kernel_name = 'hybrid_rwkv7_rglru_block'


def rmsnorm(x, g):
    xf = x.astype(jnp.float32)
    y = xf * lax.rsqrt(jnp.mean(xf * xf, axis=-1, keepdims=True) + RMS_EPS)
    return (y * g.astype(jnp.float32)).astype(x.dtype)


def token_shift(p, mu):
    prev = jnp.pad(p[:, :-1], ((0, 0), (1, 0), (0, 0)))
    return p + (prev - p) * mu


def wkv7_scan(r, w, k, v, a_vec, b_vec):
    B, _, H, N = r.shape
    xs = tuple(jnp.moveaxis(t, 1, 0) for t in (r, w, k, v, a_vec, b_vec))

    def step(S, inp):
        r_t, w_t, k_t, v_t, a_t, b_t = inp
        sa = jnp.einsum('bhvk,bhk->bhv', S, a_t)
        S = S * w_t[:, :, None, :] + sa[..., None] * b_t[:, :, None, :] + v_t[..., None] * k_t[:, :, None, :]
        y_t = jnp.einsum('bhvk,bhk->bhv', S, r_t)
        return S, y_t

    S0 = jnp.zeros((B, H, N, N), jnp.float32)
    _, y = lax.scan(step, S0, xs)
    return jnp.moveaxis(y, 0, 1)


def rwkv7_time_mix(pa, mu_shift, w0, w_decay_up, a0, w_aaa_up, w_gate_up, k_k, k_a, r_k, ln_x_w, ln_x_b):
    dt = pa.dtype
    B, T, _ = pa.shape
    f32 = jnp.float32
    xs = token_shift(pa, mu_shift)
    r, k, v, wd, ad, gd = jnp.split(xs, RWKV_SPLITS, axis=-1)
    w_log = -jax.nn.softplus(-(w0 + jnp.tanh(wd) @ w_decay_up).astype(f32)) - 0.5
    decay = jnp.exp(-jnp.exp(w_log))
    a = jax.nn.sigmoid((a0 + ad @ w_aaa_up).astype(f32))
    g = jax.nn.sigmoid(gd) @ w_gate_up
    kf = k.astype(f32)
    kk = (kf * k_k.astype(f32)).reshape(B, T, N_HEADS_A, HEAD_SIZE_A)
    kk = kk / jnp.maximum(jnp.sqrt(jnp.sum(kk * kk, axis=-1, keepdims=True)), 1e-12)
    kmod = kf * (1.0 + (a - 1.0) * k_a.astype(f32))
    heads = lambda t: t.astype(f32).reshape(B, T, N_HEADS_A, HEAD_SIZE_A)
    rh, kh, vh, ah, dh = heads(r), heads(kmod), heads(v), heads(a), heads(decay)
    y = wkv7_scan(rh, dh, kh, vh, -kk, kk * ah)
    mean = jnp.mean(y, axis=-1, keepdims=True)
    var = jnp.mean(jnp.square(y - mean), axis=-1, keepdims=True)
    y = ((y - mean) * lax.rsqrt(var + LN_X_EPS)).reshape(B, T, WIDTH_A) * ln_x_w + ln_x_b
    bonus = jnp.sum(rh * kh * r_k.astype(f32), axis=-1, keepdims=True) * vh
    y = y + bonus.reshape(B, T, WIDTH_A)
    return (y * g).astype(dt)


def _lin_combine(c1, c2):
    a1, b1 = c1
    a2, b2 = c2
    return a1 * a2, a2 * b1 + b2


def rglru_branch(xb, yb, conv_w, conv_b, lru_wa, lru_ba, lru_wx, lru_bx, lru_lambda):
    dt = xb.dtype
    B, T, _ = xb.shape
    f32 = jnp.float32
    xp = jnp.pad(xb, ((0, 0), (CONV_WIDTH - 1, 0), (0, 0)))
    xc = conv_b + sum(xp[:, j:j + T] * conv_w[j] for j in range(CONV_WIDTH))
    xh = xc.reshape(B, T, N_BLOCKS_B, BLOCK_B)
    gate_r = jax.nn.sigmoid((jnp.einsum('bthi,hij->bthj', xh, lru_wa).reshape(B, T, WIDTH_B) + lru_ba).astype(f32))
    gate_i = jax.nn.sigmoid((jnp.einsum('bthi,hij->bthj', xh, lru_wx).reshape(B, T, WIDTH_B) + lru_bx).astype(f32))
    log_a = -LRU_C * jax.nn.softplus(-lru_lambda.astype(f32)) * gate_r
    a = jnp.exp(log_a)
    b = jnp.sqrt(-jnp.expm1(2.0 * log_a)) * (gate_i * xc.astype(f32))
    _, hs = lax.associative_scan(_lin_combine, (a, b), axis=1)
    return (hs * jax.nn.gelu(yb.astype(f32))).astype(dt)


def hybrid_layer(h, norm_mix_g, w_in, mu_shift, w0, w_decay_up, a0, w_aaa_up, w_gate_up, k_k, k_a, r_k,
                 ln_x_w, ln_x_b, w_proj_a, conv_w, conv_b, lru_wa, lru_ba, lru_wx, lru_bx, lru_lambda,
                 w_proj_b, w_out, norm_ffn_g, w_ff_up, w_ff_down):
    u = rmsnorm(h, norm_mix_g)
    p = u @ w_in
    pa, xb, yb, gates = jnp.split(p, (COLS_A, COLS_A + WIDTH_B, COLS_A + 2 * WIDTH_B), axis=-1)
    ya = rwkv7_time_mix(pa, mu_shift, w0, w_decay_up, a0, w_aaa_up, w_gate_up, k_k, k_a, r_k, ln_x_w, ln_x_b) @ w_proj_a
    yr = rglru_branch(xb, yb, conv_w, conv_b, lru_wa, lru_ba, lru_wx, lru_bx, lru_lambda) @ w_proj_b
    ga, gb = jnp.split(jax.nn.sigmoid(gates), 2, axis=-1)
    h = h + ((ga * ya + gb * yr) @ w_out).astype(h.dtype)
    z = rmsnorm(h, norm_ffn_g) @ w_ff_up
    h = h + (jnp.square(jax.nn.relu(z)) @ w_ff_down).astype(h.dtype)
    return h


def setup_inputs(seed: int = 0) -> dict:
    key = jax.random.key(seed)
    ks = jax.random.split(key, 32)
    f32 = jnp.float32
    nrm = lambda k, shape, s: s * jax.random.normal(k, shape, f32)
    L = DEPTH
    lin = jnp.linspace(0.0, 1.0, WIDTH_A, dtype=f32)
    u_lam = jax.random.uniform(ks[24], (L, WIDTH_B), f32, 0.9, 0.999)
    root = u_lam ** (1.0 / LRU_C)
    return {
        'x': nrm(ks[0], (BATCH, SEQ, D_MODEL), 1.0),
        'meta_tokens': nrm(ks[1], (N_META, D_MODEL), 1.0),
        'norm_mix_g': 1.0 + nrm(ks[2], (L, D_MODEL), 0.02),
        'w_in': nrm(ks[3], (L, D_MODEL, N_IN_COLS), D_MODEL ** -0.5),
        'mu_shift': jax.random.uniform(ks[4], (L, COLS_A), f32),
        'w0': -7.0 + 5.0 * lin ** 0.85 + nrm(ks[5], (L, WIDTH_A), 0.1),
        'w_decay_up': nrm(ks[6], (L, DECAY_LORA, WIDTH_A), 0.1),
        'a0': nrm(ks[7], (L, WIDTH_A), 0.1),
        'w_aaa_up': nrm(ks[8], (L, AAA_LORA, WIDTH_A), 0.5 * AAA_LORA ** -0.5),
        'w_gate_up': nrm(ks[9], (L, GATE_LORA, WIDTH_A), GATE_LORA ** -0.5),
        'k_k': 0.85 + nrm(ks[10], (L, WIDTH_A), 0.05),
        'k_a': 1.0 + nrm(ks[11], (L, WIDTH_A), 0.05),
        'r_k': nrm(ks[12], (L, N_HEADS_A, HEAD_SIZE_A), 0.1),
        'ln_x_w': 1.0 + nrm(ks[13], (L, WIDTH_A), 0.02),
        'ln_x_b': nrm(ks[14], (L, WIDTH_A), 0.02),
        'w_proj_a': nrm(ks[15], (L, WIDTH_A, D_MODEL), WIDTH_A ** -0.5),
        'conv_w': nrm(ks[16], (L, CONV_WIDTH, WIDTH_B), CONV_WIDTH ** -0.5),
        'conv_b': nrm(ks[17], (L, WIDTH_B), 0.02),
        'lru_wa': nrm(ks[18], (L, N_BLOCKS_B, BLOCK_B, BLOCK_B), BLOCK_B ** -0.5),
        'lru_ba': nrm(ks[19], (L, WIDTH_B), 0.02),
        'lru_wx': nrm(ks[20], (L, N_BLOCKS_B, BLOCK_B, BLOCK_B), BLOCK_B ** -0.5),
        'lru_bx': nrm(ks[21], (L, WIDTH_B), 0.02),
        'lru_lambda': jnp.log(root) - jnp.log1p(-root),
        'w_proj_b': nrm(ks[22], (L, WIDTH_B, D_MODEL), WIDTH_B ** -0.5),
        'w_out': nrm(ks[23], (L, D_MODEL, D_MODEL), D_MODEL ** -0.5),
        'norm_ffn_g': 1.0 + nrm(ks[25], (L, D_MODEL), 0.02),
        'w_ff_up': nrm(ks[26], (L, D_MODEL, D_FF), D_MODEL ** -0.5),
        'w_ff_down': nrm(ks[27], (L, D_FF, D_MODEL), D_FF ** -0.5),
        'norm_final_g': 1.0 + nrm(ks[28], (D_MODEL,), 0.02),
    }


def reference(x, meta_tokens, norm_mix_g, w_in, mu_shift, w0, w_decay_up, a0, w_aaa_up, w_gate_up, k_k, k_a,
              r_k, ln_x_w, ln_x_b, w_proj_a, conv_w, conv_b, lru_wa, lru_ba, lru_wx, lru_bx, lru_lambda,
              w_proj_b, w_out, norm_ffn_g, w_ff_up, w_ff_down, norm_final_g):
    B = x.shape[0]
    meta = jnp.broadcast_to(meta_tokens.astype(x.dtype)[None], (B, N_META, D_MODEL))
    h = jnp.concatenate([meta, x], axis=1)
    layer_params = (norm_mix_g, w_in, mu_shift, w0, w_decay_up, a0, w_aaa_up, w_gate_up, k_k, k_a, r_k,
                    ln_x_w, ln_x_b, w_proj_a, conv_w, conv_b, lru_wa, lru_ba, lru_wx, lru_bx, lru_lambda,
                    w_proj_b, w_out, norm_ffn_g, w_ff_up, w_ff_down)
    for l in range(DEPTH):
        h = hybrid_layer(h, *(p[l] for p in layer_params))
    h = rmsnorm(h, norm_final_g)
    return h[:, N_META:]
```

```cpp
#include <hip/hip_runtime.h>
#include <hip/hip_cooperative_groups.h>
#include <cstdio>
#include <cstdint>
namespace cg = cooperative_groups;

#define GAS __attribute__((address_space(1)))
#define LAS __attribute__((address_space(3)))
typedef unsigned short bf16;
typedef unsigned v4u __attribute__((ext_vector_type(4)));
typedef unsigned v2u __attribute__((ext_vector_type(2)));
typedef float f32x4 __attribute__((ext_vector_type(4)));
typedef float f32x2 __attribute__((ext_vector_type(2)));
typedef short bf16x8 __attribute__((ext_vector_type(8)));

namespace pg8 {
constexpr int BM = 256, BK = 64, HALF = 128, HTB = HALF * BK * 2, STAGE_BYTES = 8 * HTB, NXCD = 8, WGM = 8;
__host__ __device__ __forceinline__ int lds_byte(int r, int c) { const int st = (r >> 4) * 2 + (c >> 5), rr = r & 15, cc = c & 31, ob = rr * 64 + cc * 2; return st * 1024 + (ob ^ (((ob >> 9) & 1) << 5)); }
__host__ __device__ __forceinline__ void stage_rc(int b, int& R, int& C) { const int st = b / 1024, sb = b % 1024, swz = sb ^ (((sb >> 9) & 1) << 5); R = (st >> 1) * 16 + swz / 64; C = (st & 1) * 32 + (swz % 64) / 2; }
__host__ __device__ __forceinline__ int perm32(int rho) { const int n = rho >> 4, i = rho & 15; return 8 * (i >> 2) + 4 * n + (i & 3); }
struct Unit { int pm, pn; };
struct Gemm { const bf16* A; const bf16* Bt; int M, N, K, lda, ash, amul; };
struct StaticOrder {
    int nM, nN, nwg, G, c;
    __host__ __device__ void init(int M, int N, int G_, int c_) { nM = M / BM; nN = N / BM; nwg = nM * nN; G = G_; c = c_; }
    __host__ __device__ bool next(int i, Unit& u) const {
        const long L = (long)i * G + c; if (L >= nwg) return false;
        int wgid = (int)L; { const int q = nwg / NXCD, r = nwg % NXCD, xcd = wgid % NXCD, off = wgid / NXCD; wgid = (xcd < r ? xcd * (q + 1) : r * (q + 1) + (xcd - r) * q) + off; }
        const int nig = WGM * nN, gid = wgid / nig, fm = gid * WGM, gsz = (nM - fm) < WGM ? (nM - fm) : WGM;
        u.pm = fm + ((wgid % nig) % gsz); u.pn = (wgid % nig) / gsz; return true;
    }
};
template <class Op> struct EpiOp {
    static constexpr bool PERM = true;
    Op op;
    __device__ __forceinline__ void operator()(const f32x4 (&acc)[2][2][4][2], const Unit& u, int wr, int wc, int fr, int fq) const {
        int row0 = u.pm * BM + wr * 64 + fr, col0 = u.pn * BM + wc * 32 + 8 * fq;
        asm volatile("" : "+v"(row0), "+v"(col0));
#pragma unroll
        for (int ai = 0; ai < 2; ++ai)
#pragma unroll
            for (int m = 0; m < 4; ++m)
                { op(row0 + ai * HALF + m * 16, col0, acc[ai][0][m][0], acc[ai][0][m][1]); op(row0 + ai * HALF + m * 16, col0 + HALF, acc[ai][1][m][0], acc[ai][1][m][1]); asm volatile("" ::: "memory"); }
    }
};

template <class Epi, class Sched, bool ALIGN_EPI>
__device__ __forceinline__ void gemm_phase(LAS unsigned char* lds, const Gemm g, const Sched& S, const Epi& E) {
    int tid = threadIdx.x; asm volatile("" : "+v"(tid));
    const int wid = __builtin_amdgcn_readfirstlane(tid >> 6), lane = tid & 63, wr = wid >> 2, wc = wid & 3, fr = lane & 15, fq = lane >> 4;
    const int K = g.K, nt = K / BK;
    unsigned voffA[2], voffB[2];
#pragma unroll
    for (int i = 0; i < 2; ++i) { int R, C; stage_rc(tid * 16 + i * 8192, R, C); const int Rb = Epi::PERM ? ((R & ~31) + perm32(R & 31)) : R;
        voffA[i] = (unsigned)(R * g.lda + C) * 2u; voffB[i] = (unsigned)(Rb * K + C) * 2u; }
    const size_t kstep = (size_t)(BK * 2);
    const size_t hstepA = (size_t)HALF * g.lda * 2, hstepB = (size_t)HALF * K * 2;
    const size_t tstepA = 2 * hstepA, tstepB = 2 * hstepB;
    const unsigned ldsw = (unsigned)wid * 1024u;
    const int aoff = lds_byte(wr * 64 + fr, fq * 8), boff = lds_byte(wc * 32 + fr, fq * 8);
#define PG8_SA(b, h) (((b) * 2 + (h)) * HTB)
#define PG8_SB(b, h) ((4 + (b) * 2 + (h)) * HTB)
#define PG8_STAGE(bufoff, gbase, voff) do { _Pragma("unroll") for (int _i = 0; _i < 2; ++_i) \
        __builtin_amdgcn_global_load_lds((const unsigned*)((const char*)(gbase) + (voff)[_i]), (LAS unsigned*)(lds + (bufoff) + ldsw + _i * 8192), 16, 0, 0); } while (0)
#define PG8_LDA(dst, b, h) do { _Pragma("unroll") for (int m = 0; m < 4; ++m) _Pragma("unroll") for (int k = 0; k < 2; ++k) dst[m][k] = *(const LAS bf16x8*)(lds + PG8_SA(b, h) + aoff + m * 2048 + k * 1024); } while (0)
#define PG8_LDB(dst, b, h) do { _Pragma("unroll") for (int n = 0; n < 2; ++n) _Pragma("unroll") for (int k = 0; k < 2; ++k) dst[n][k] = *(const LAS bf16x8*)(lds + PG8_SB(b, h) + boff + n * 2048 + k * 1024); } while (0)
#define PG8_MMA(ai, bj, At, Bt) do { __builtin_amdgcn_s_setprio(1); _Pragma("unroll") for (int m = 0; m < 4; ++m) _Pragma("unroll") for (int n = 0; n < 2; ++n) _Pragma("unroll") for (int k = 0; k < 2; ++k) \
        acc[ai][bj][m][n] = __builtin_amdgcn_mfma_f32_16x16x32_bf16(Bt[n][k], At[m][k], acc[ai][bj][m][n], 0, 0, 0); __builtin_amdgcn_s_setprio(0); } while (0)
#define PG8_WAIT_V(n) asm volatile("s_waitcnt vmcnt(" #n ")" ::: "memory")
#define PG8_WAIT_L(n) asm volatile("s_waitcnt lgkmcnt(" #n ")" ::: "memory")
#define PG8_BAR __builtin_amdgcn_s_barrier()
#define PG8_SCHED __builtin_amdgcn_sched_barrier(0)
#define PG8_UA(u) ((const char*)g.A + (size_t)(u).pm * tstepA + (size_t)(((u).pn >> g.ash) * g.amul) * 2)
#define PG8_UB(u) ((const char*)g.Bt + (size_t)(u).pn * tstepB)
    Unit cur, nxt; int ui = 0;
    if (!S.next(0, cur)) return;
    f32x4 acc[2][2][4][2];
#pragma unroll
    for (int a = 0; a < 2; ++a)
#pragma unroll
        for (int b = 0; b < 2; ++b)
#pragma unroll
            for (int m = 0; m < 4; ++m)
#pragma unroll
                for (int n = 0; n < 2; ++n) acc[a][b][m][n] = (f32x4){0.f, 0.f, 0.f, 0.f};
    bf16x8 At[4][2], B0[2][2], B1[2][2];
    const char* cA = PG8_UA(cur); const char* cB = PG8_UB(cur);
    PG8_STAGE(PG8_SB(0, 0), cB, voffB); PG8_STAGE(PG8_SB(0, 1), cB + hstepB, voffB); PG8_STAGE(PG8_SA(0, 0), cA, voffA); PG8_STAGE(PG8_SA(0, 1), cA + hstepA, voffA);
    if (wr == 1) PG8_BAR;
    PG8_WAIT_V(2); PG8_BAR;
    PG8_STAGE(PG8_SB(1, 0), cB + kstep, voffB); PG8_STAGE(PG8_SA(1, 0), cA + kstep, voffA); PG8_STAGE(PG8_SB(1, 1), cB + hstepB + kstep, voffB);
    PG8_WAIT_V(6); PG8_BAR;
    for (;;) {
        const bool has_next = S.next(ui + 1, nxt);
        const char* nA = has_next ? PG8_UA(nxt) : cA; const char* nB = has_next ? PG8_UB(nxt) : cB;
        for (int t = 0; t < nt; t += 2) {
            const bool last = (t == nt - 2);
            const char* a1 = cA + (size_t)(t + 1) * kstep;
            const char* a2 = last ? nA : cA + (size_t)(t + 2) * kstep; const char* b2 = last ? nB : cB + (size_t)(t + 2) * kstep;
            const char* a3 = a2 + kstep; const char* b3 = b2 + kstep;
            PG8_LDB(B0, 0, 0); PG8_LDB(B1, 0, 1); PG8_SCHED; PG8_LDA(At, 0, 0); PG8_STAGE(PG8_SA(1, 1), a1 + hstepA, voffA);
            PG8_WAIT_V(8); PG8_WAIT_L(0); PG8_BAR; PG8_MMA(0, 0, At, B0); PG8_MMA(0, 1, At, B1); PG8_BAR; PG8_SCHED;
            PG8_LDA(At, 0, 1); PG8_STAGE(PG8_SB(0, 0), b2, voffB); PG8_STAGE(PG8_SB(0, 1), b2 + hstepB, voffB); PG8_STAGE(PG8_SA(0, 0), a2, voffA);
            PG8_WAIT_V(8); PG8_WAIT_L(0); PG8_BAR; PG8_MMA(1, 0, At, B0); PG8_MMA(1, 1, At, B1); PG8_BAR; PG8_SCHED;
            PG8_LDB(B0, 1, 0); PG8_LDB(B1, 1, 1); PG8_SCHED; PG8_LDA(At, 1, 0); PG8_STAGE(PG8_SA(0, 1), a2 + hstepA, voffA);
            PG8_WAIT_V(8); PG8_WAIT_L(0); PG8_BAR; PG8_MMA(0, 0, At, B0); PG8_MMA(0, 1, At, B1); PG8_BAR; PG8_SCHED;
            PG8_LDA(At, 1, 1); PG8_STAGE(PG8_SB(1, 0), b3, voffB); PG8_STAGE(PG8_SB(1, 1), b3 + hstepB, voffB); PG8_STAGE(PG8_SA(1, 0), a3, voffA);
            PG8_WAIT_V(8); PG8_WAIT_L(0); PG8_BAR; PG8_MMA(1, 0, At, B0); PG8_MMA(1, 1, At, B1); PG8_BAR; PG8_SCHED;
        }
        if constexpr (ALIGN_EPI) { if (wr == 0) PG8_BAR; }
        E(acc, cur, wr, wc, fr, fq);
        if (!has_next) break;
#pragma unroll
        for (int a = 0; a < 2; ++a)
#pragma unroll
            for (int b = 0; b < 2; ++b)
#pragma unroll
                for (int m = 0; m < 4; ++m)
#pragma unroll
                    for (int n = 0; n < 2; ++n) acc[a][b][m][n] = (f32x4){0.f, 0.f, 0.f, 0.f};
        cur = nxt; cA = nA; cB = nB; ++ui;
        if constexpr (ALIGN_EPI) { if (wr == 1) PG8_BAR; }
    }
    PG8_WAIT_V(0);
    if constexpr (!ALIGN_EPI) { if (wr == 0) PG8_BAR; }
    PG8_BAR;
#undef PG8_SA
#undef PG8_SB
#undef PG8_STAGE
#undef PG8_LDA
#undef PG8_LDB
#undef PG8_MMA
#undef PG8_WAIT_V
#undef PG8_WAIT_L
#undef PG8_BAR
#undef PG8_SCHED
#undef PG8_UA
#undef PG8_UB
}
}

constexpr int NB = 4, TT = 8208, NMETA = 16, SEQ = 8192, D = 1024, NCOL = 7424, PC = 5376, FF = 4096, NH = 16;
constexpr int MT = NB * SEQ;
constexpr int LGSEG = 11, SEGMAX = 1 << LGSEG, MSEGMAX = NB * SEGMAX;
constexpr int NSEG = 1 + SEQ / SEGMAX;
constexpr int OFF_WD = 3072, OFF_XB = 3328, OFF_YB = 4352;
constexpr float RMS_EPS = 1e-6f, LNX_EPS = 64e-5f;

constexpr size_t MiB = 1u << 20;
constexpr size_t WS_BAR = 4 * MiB + 131072;
constexpr size_t WS_SST = 0 * MiB, WS_CHA = 1 * MiB, WS_CHB = 2 * MiB, WS_CAR = 3 * MiB, WS_LST = 4 * MiB, WS_CL = 4 * MiB + 65536;
constexpr size_t WS_WIN = 5 * MiB, WS_WPA = 20 * MiB, WS_WPB = 22 * MiB, WS_WOUT = 24 * MiB, WS_WUP = 26 * MiB, WS_WDN = 34 * MiB, WS_WLORA = 42 * MiB, WS_WLRU = 43 * MiB;
constexpr size_t WS_YA = 44 * MiB, WS_YB = 108 * MiB;
constexpr size_t WS_XN = 172 * MiB, WS_P = 188 * MiB, WS_HALO = 272 * MiB, WS_LA = 273 * MiB, WS_XC = 277 * MiB, WS_L = 293 * MiB, WS_LRA = 341 * MiB, WS_LRB = 373 * MiB;
constexpr size_t WS_R = 389 * MiB  , WS_Y = 390 * MiB, WS_END = 422 * MiB;
static_assert(WS_XN + (size_t)MSEGMAX * D * 2 <= WS_P && WS_P + (size_t)MSEGMAX * PC * 2 <= WS_HALO && WS_LA + (size_t)MSEGMAX * 256 * 2 <= WS_XC && WS_XC + (size_t)MSEGMAX * 1024 * 2 <= WS_L && WS_L + (size_t)MSEGMAX * 3072 * 2 <= WS_LRA && WS_LRA + (size_t)MSEGMAX * 1024 * 4 <= WS_LRB && WS_LRB + (size_t)MSEGMAX * 1024 * 2 <= WS_R && WS_Y + (size_t)MSEGMAX * 1024 * 4 <= WS_END, "segment buffers");
constexpr size_t WS_T1 = 172 * MiB, WS_MIX = 300 * MiB, WS_XN2 = 364 * MiB, WS_Z = 44 * MiB, WS_TAIL_END = 428 * MiB;
constexpr int LDS_BYTES = 135168;

struct Params {
    const float *x, *meta, *norm_mix_g, *w_in, *mu, *w0, *w_decay_up, *a0, *w_aaa_up, *w_gate_up, *k_k, *k_a, *r_k, *ln_w, *ln_b, *w_proj_a, *conv_w, *conv_b,
        *lru_wa, *lru_ba, *lru_wx, *lru_bx, *lru_lambda, *w_proj_b, *w_out, *norm_ffn_g, *w_ff_up, *w_ff_down, *norm_final_g;
    float* out; unsigned char* ws;
};

__device__ __forceinline__ int opaque(int x) { asm volatile("" : "+v"(x)); return x; }
__device__ __forceinline__ unsigned f2bf(float f) { unsigned u = __builtin_bit_cast(unsigned, f); return (u + 0x7fffu + ((u >> 16) & 1u)) >> 16; }
__device__ __forceinline__ unsigned pk2(float lo, float hi) { unsigned r; asm("v_cvt_pk_bf16_f32 %0, %1, %2" : "=v"(r) : "v"(lo), "v"(hi)); return r; }
__device__ __forceinline__ float bflo(unsigned w) { return __builtin_bit_cast(float, w << 16); }
__device__ __forceinline__ float bfhi(unsigned w) { return __builtin_bit_cast(float, w & 0xffff0000u); }
__device__ __forceinline__ float bf1(bf16 h) { return __builtin_bit_cast(float, (unsigned)h << 16); }
__device__ __forceinline__ float rcpf_(float x) { return __builtin_amdgcn_rcpf(x); }
__device__ __forceinline__ float rsqf_(float x) { return __builtin_amdgcn_rsqf(x); }
__device__ __forceinline__ float sqrtf_(float x) { return __builtin_amdgcn_sqrtf(x); }
__device__ __forceinline__ float sigmoidf_(float x) { return rcpf_(1.0f + __expf(-x)); }
__device__ __forceinline__ float tanhf_(float x) { return 1.0f - 2.0f * rcpf_(__expf(2.0f * x) + 1.0f); }
__device__ __forceinline__ float gelu_tanh(float x) { return 0.5f * x * (1.0f + tanhf_(0.7978845608028654f * (x + 0.044715f * x * x * x))); }
__device__ __forceinline__ v4u pack8(f32x4 a, f32x4 b) { v4u w; w.x = pk2(a.x, a.y); w.y = pk2(a.z, a.w); w.z = pk2(b.x, b.y); w.w = pk2(b.z, b.w); return w; }
__device__ __forceinline__ void unpack8(v4u w, float* o) { o[0] = bflo(w.x); o[1] = bfhi(w.x); o[2] = bflo(w.y); o[3] = bfhi(w.y); o[4] = bflo(w.z); o[5] = bfhi(w.z); o[6] = bflo(w.w); o[7] = bfhi(w.w); }
template <int CTRL> __device__ __forceinline__ float dppx(float v) { return __builtin_bit_cast(float, __builtin_amdgcn_update_dpp(0, __builtin_bit_cast(int, v), CTRL, 0xf, 0xf, true)); }
__device__ __forceinline__ float wave_sum(float v) {
    v += dppx<0xB1>(v); v += dppx<0x4E>(v); v += dppx<0x141>(v); v += dppx<0x140>(v);
    v += __shfl_xor(v, 16); v += __shfl_xor(v, 32);
    return v;
}
__device__ __forceinline__ float quad_sum(float v) { v += dppx<0xB1>(v); v += dppx<0x4E>(v); return v; }
__device__ __forceinline__ void load16bf(const bf16* p, float* o) { const v4u a = *(const v4u*)p, b = *(const v4u*)(p + 8); unpack8(a, o); unpack8(b, o + 8); }
__device__ __forceinline__ void load16f(const float* p, float* o) {
#pragma unroll
    for (int j = 0; j < 4; ++j) { const f32x4 v = *(const f32x4*)(p + 4 * j); o[4 * j] = v.x; o[4 * j + 1] = v.y; o[4 * j + 2] = v.z; o[4 * j + 3] = v.w; }
}
__device__ __forceinline__ void store16f(float* p, const float* o) {
#pragma unroll
    for (int j = 0; j < 4; ++j) *(f32x4*)(p + 4 * j) = (f32x4){o[4 * j], o[4 * j + 1], o[4 * j + 2], o[4 * j + 3]};
}
__device__ __forceinline__ void store16bf(bf16* p, const float* o) {
    v4u a, b; a.x = pk2(o[0], o[1]); a.y = pk2(o[2], o[3]); a.z = pk2(o[4], o[5]); a.w = pk2(o[6], o[7]); b.x = pk2(o[8], o[9]); b.y = pk2(o[10], o[11]); b.z = pk2(o[12], o[13]); b.w = pk2(o[14], o[15]);
    *(v4u*)p = a; *(v4u*)(p + 8) = b;
}
__device__ __forceinline__ void shift16(const bf16* cur, const bf16* prev, const float* mu, float* o) {
    float c[16], q[16], m[16]; load16bf(cur, c); load16bf(prev, q); load16f(mu, m);
#pragma unroll
    for (int j = 0; j < 16; ++j) o[j] = c[j] + (q[j] - c[j]) * m[j];
}

__device__ __forceinline__ void transpose_item(const float* W, int K, int N, bf16* WT, LAS float* scr, int item, int lane) {
    const int nblk = N / 32, kb = item / nblk, nb = item % nblk, k0 = 64 * kb, n0 = 32 * nb;
    float wv[32];
#pragma unroll
    for (int i = 0; i < 32; ++i) wv[i] = W[(size_t)(k0 + 2 * i + (lane >> 5)) * N + n0 + (lane & 31)];
#pragma unroll
    for (int i = 0; i < 32; ++i) scr[(2 * i + (lane >> 5)) * 33 + (lane & 31)] = wv[i];
    asm volatile("s_waitcnt lgkmcnt(0)" ::: "memory");
    const int c = lane & 7;
#pragma unroll
    for (int j = 0; j < 4; ++j) { const int n = (lane >> 3) + 8 * j; const LAS float* s = scr + (8 * c) * 33 + n;
        v4u o; o.x = pk2(s[0 * 33], s[1 * 33]); o.y = pk2(s[2 * 33], s[3 * 33]); o.z = pk2(s[4 * 33], s[5 * 33]); o.w = pk2(s[6 * 33], s[7 * 33]);
        *(v4u*)(WT + (size_t)(n0 + n) * K + k0 + 8 * c) = o; }
    asm volatile("s_waitcnt lgkmcnt(0)" ::: "memory");
}
__device__ __forceinline__ void rms_row_to_bf16(const float* xrow, const float* g, bf16* orow, int lane) {
    f32x4 v[4]; float s = 0.f;
#pragma unroll
    for (int j = 0; j < 4; ++j) { v[j] = *((const f32x4*)xrow + lane + 64 * j); s += (v[j].x * v[j].x + v[j].y * v[j].y) + (v[j].z * v[j].z + v[j].w * v[j].w); }
    const float sc = rsqf_(wave_sum(s) * (1.f / D) + RMS_EPS);
#pragma unroll
    for (int j = 0; j < 4; ++j) { const f32x4 gg = *((const f32x4*)g + lane + 64 * j); v2u o; o.x = pk2(v[j].x * sc * gg.x, v[j].y * sc * gg.y); o.y = pk2(v[j].z * sc * gg.z, v[j].w * sc * gg.w);
        *((v2u*)orow + lane + 64 * j) = o; }
}

__device__ __forceinline__ void rms_rows4_to_bf16(const float* x0, const float* x1, const float* x2, const float* x3, const float* g, bf16* o0, bf16* o1, bf16* o2, bf16* o3, int lane) {
    const float* xs[4] = {x0, x1, x2, x3}; bf16* os[4] = {o0, o1, o2, o3};
    f32x4 v[4][4];
#pragma unroll
    for (int r = 0; r < 4; ++r)
#pragma unroll
        for (int j = 0; j < 4; ++j) v[r][j] = *((const f32x4*)xs[r] + lane + 64 * j);
    f32x4 gg[4];
#pragma unroll
    for (int j = 0; j < 4; ++j) gg[j] = *((const f32x4*)g + lane + 64 * j);
#pragma unroll
    for (int r = 0; r < 4; ++r) {
        float s = 0.f;
#pragma unroll
        for (int j = 0; j < 4; ++j) s += (v[r][j].x * v[r][j].x + v[r][j].y * v[r][j].y) + (v[r][j].z * v[r][j].z + v[r][j].w * v[r][j].w);
        const float sc = rsqf_(wave_sum(s) * (1.f / D) + RMS_EPS);
#pragma unroll
        for (int j = 0; j < 4; ++j) { v2u o; o.x = pk2(v[r][j].x * sc * gg[j].x, v[r][j].y * sc * gg[j].y); o.y = pk2(v[r][j].z * sc * gg[j].z, v[r][j].w * sc * gg[j].w); *((v2u*)os[r] + lane + 64 * j) = o; }
    }
}

struct OpP {
    bf16* P; bf16* halo_next; bf16* gates; int Mseg, lgT, gbase, s;
    __device__ __forceinline__ void operator()(int row, int col, f32x4 v0, f32x4 v1) const {
        if (row >= Mseg) return;
        const v4u w = pack8(v0, v1); const int b = row >> lgT, SEGT = 1 << lgT, i = row & (SEGT - 1);
        if (col < PC) {
            *(v4u*)(P + (size_t)row * PC + col) = w;
            if (i >= SEGT - 3) *(v4u*)(halo_next + (size_t)(b * 3 + (i - (SEGT - 3))) * PC + col) = w;
        } else if (s > 0) {
            *(v4u*)(gates + ((size_t)b * SEQ + gbase + i) * 2048 + (col - PC)) = w;
        }
    }
};
struct OpLora {
    bf16* L; int Mseg;
    __device__ __forceinline__ void operator()(int row, int col, f32x4 v0, f32x4 v1) const {
        if (row >= Mseg) return;
        *(v4u*)(L + (size_t)row * 3072 + col) = pack8(v0, v1);
    }
};
struct OpLru {
    float* LRA; bf16* LRB; const bf16* XC; const float* CL; const float* ba; const float* bx; int Mseg;
    __device__ __forceinline__ void operator()(int row, int col, f32x4 v0, f32x4 v1) const {
        if (row >= Mseg) return;
        float v[8] = {v0.x, v0.y, v0.z, v0.w, v1.x, v1.y, v1.z, v1.w};
        const int pj = col >> 8, nn = col & 255, blk = nn >> 7, gate = (nn >> 6) & 1, j = nn & 63, ch = 64 * (2 * pj + blk) + j;
        if (gate == 0) {
            float cl[8], bb[8]; { const f32x4 c0 = *(const f32x4*)(CL + ch), c1 = *(const f32x4*)(CL + ch + 4), b0 = *(const f32x4*)(ba + ch), b1 = *(const f32x4*)(ba + ch + 4);
                cl[0] = c0.x; cl[1] = c0.y; cl[2] = c0.z; cl[3] = c0.w; cl[4] = c1.x; cl[5] = c1.y; cl[6] = c1.z; cl[7] = c1.w; bb[0] = b0.x; bb[1] = b0.y; bb[2] = b0.z; bb[3] = b0.w; bb[4] = b1.x; bb[5] = b1.y; bb[6] = b1.z; bb[7] = b1.w; }
#pragma unroll
            for (int e = 0; e < 8; ++e) v[e] = __expf(cl[e] * sigmoidf_(v[e] + bb[e]));
            float* o = LRA + (size_t)row * 1024 + ch;
            *(f32x4*)o = (f32x4){v[0], v[1], v[2], v[3]}; *(f32x4*)(o + 4) = (f32x4){v[4], v[5], v[6], v[7]};
        } else {
            float xc[8]; unpack8(*(const v4u*)(XC + (size_t)row * 1024 + ch), xc);
            float bb[8]; { const f32x4 b0 = *(const f32x4*)(bx + ch), b1 = *(const f32x4*)(bx + ch + 4); bb[0] = b0.x; bb[1] = b0.y; bb[2] = b0.z; bb[3] = b0.w; bb[4] = b1.x; bb[5] = b1.y; bb[6] = b1.z; bb[7] = b1.w; }
#pragma unroll
            for (int e = 0; e < 8; ++e) v[e] = sigmoidf_(v[e] + bb[e]) * xc[e];
            *(v4u*)(LRB + (size_t)row * 1024 + ch) = pack8((f32x4){v[0], v[1], v[2], v[3]}, (f32x4){v[4], v[5], v[6], v[7]});
        }
    }
};
struct OpT1 {
    bf16* T1; const bf16* gates;
    __device__ __forceinline__ void operator()(int row, int col, f32x4 v0, f32x4 v1) const {
        float gt[8]; unpack8(*(const v4u*)(gates + (size_t)row * 2048 + col), gt);
        const f32x4 a = {sigmoidf_(gt[0]) * v0.x, sigmoidf_(gt[1]) * v0.y, sigmoidf_(gt[2]) * v0.z, sigmoidf_(gt[3]) * v0.w};
        const f32x4 b = {sigmoidf_(gt[4]) * v1.x, sigmoidf_(gt[5]) * v1.y, sigmoidf_(gt[6]) * v1.z, sigmoidf_(gt[7]) * v1.w};
        *(v4u*)(T1 + (size_t)row * 1024 + col) = pack8(a, b);
    }
};
struct OpMix {
    const bf16* T1; const bf16* gates; bf16* MIX;
    __device__ __forceinline__ void operator()(int row, int col, f32x4 v0, f32x4 v1) const {
        float gt[8], t[8]; unpack8(*(const v4u*)(gates + (size_t)row * 2048 + 1024 + col), gt); unpack8(*(const v4u*)(T1 + (size_t)row * 1024 + col), t);
        const f32x4 a = {t[0] + sigmoidf_(gt[0]) * v0.x, t[1] + sigmoidf_(gt[1]) * v0.y, t[2] + sigmoidf_(gt[2]) * v0.z, t[3] + sigmoidf_(gt[3]) * v0.w};
        const f32x4 b = {t[4] + sigmoidf_(gt[4]) * v1.x, t[5] + sigmoidf_(gt[5]) * v1.y, t[6] + sigmoidf_(gt[6]) * v1.z, t[7] + sigmoidf_(gt[7]) * v1.w};
        *(v4u*)(MIX + (size_t)row * 1024 + col) = pack8(a, b);
    }
};
struct OpH1 {
    const float* x; float* out; const float* gff; bf16* XN2; float* SS;
    __device__ __forceinline__ void operator()(int row, int col, f32x4 v0, f32x4 v1) const {
        const size_t o = (size_t)row * 1024 + col; const f32x4 a = *(const f32x4*)(x + o) + v0, b = *(const f32x4*)(x + o + 4) + v1;
        *(f32x4*)(out + o) = a; *(f32x4*)(out + o + 4) = b;
        const f32x4 g0 = *(const f32x4*)(gff + col), g1 = *(const f32x4*)(gff + col + 4);
        *(v4u*)(XN2 + o) = pack8(a * g0, b * g1);
        float ss = (a.x * a.x + a.y * a.y) + (a.z * a.z + a.w * a.w) + (b.x * b.x + b.y * b.y) + (b.z * b.z + b.w * b.w);
        ss += __shfl_xor(ss, 16); ss += __shfl_xor(ss, 32);
        if ((threadIdx.x & 63) < 16) atomicAdd(SS + row, ss);
    }
};
struct OpZ {
    bf16* Z; const float* SS;
    __device__ __forceinline__ void operator()(int row, int col, f32x4 v0, f32x4 v1) const {
        const float rs = rsqf_(SS[row] * (1.f / D) + RMS_EPS);
        f32x4 a, b;
        a.x = fmaxf(v0.x, 0.f); a.y = fmaxf(v0.y, 0.f); a.z = fmaxf(v0.z, 0.f); a.w = fmaxf(v0.w, 0.f); b.x = fmaxf(v1.x, 0.f); b.y = fmaxf(v1.y, 0.f); b.z = fmaxf(v1.z, 0.f); b.w = fmaxf(v1.w, 0.f);
        a = a * rs; b = b * rs;
        *(v4u*)(Z + (size_t)row * FF + col) = pack8(a * a, b * b);
    }
};
struct OpAcc {
    float* out;
    __device__ __forceinline__ void operator()(int row, int col, f32x4 v0, f32x4 v1) const {
        float* o = out + (size_t)row * 1024 + col; const f32x4 a = *(const f32x4*)o, b = *(const f32x4*)(o + 4);
        *(f32x4*)o = a + v0; *(f32x4*)(o + 4) = b + v1;
    }
};
template <class Op, bool ALIGN>
__device__ __forceinline__ void run_gemm(LAS unsigned char* lds, const bf16* A, int lda, const bf16* Bt, int M, int N, int K, int ash, int amul, const Op& op) {
    pg8::Gemm g{A, Bt, M, N, K, lda, ash, amul}; pg8::StaticOrder S; S.init(M, N, (int)gridDim.x, (int)blockIdx.x);
    pg8::EpiOp<Op> E{op};
    pg8::gemm_phase<pg8::EpiOp<Op>, pg8::StaticOrder, ALIGN>(lds, g, S, E);
}

constexpr int CH = 32, REC = 336  , CHBYTES = CH * REC * 4;
__device__ __forceinline__ float dppf(float v, const int ctrl_sel) {
    const int x = __builtin_bit_cast(int, v); int r;
    if (ctrl_sel == 0) r = __builtin_amdgcn_update_dpp(0, x, 0xB1, 0xf, 0xf, true);
    else if (ctrl_sel == 1) r = __builtin_amdgcn_update_dpp(0, x, 0x4E, 0xf, 0xf, true);
    else if (ctrl_sel == 2) r = __builtin_amdgcn_update_dpp(0, x, 0x141, 0xf, 0xf, true);
    else r = __builtin_amdgcn_update_dpp(0, x, 0x140, 0xf, 0xf, true);
    return __builtin_bit_cast(float, r);
}
__device__ __forceinline__ float red16(float v) { v += dppf(v, 0); v += dppf(v, 1); v += dppf(v, 2); v += dppf(v, 3); return v; }

__device__ __forceinline__ float red32(float v) {
    v = red16(v); float a = v, b = v;
    asm volatile("s_nop 1\n\tv_permlane16_swap_b32 %0, %1" : "+v"(a), "+v"(b));
    return a + b;
}
struct ScanRegs { f32x4 a[5]; f32x4 v; };
__device__ __forceinline__ void scan_load(ScanRegs& R, const float* const* arr, const float* V, int mrow, int hcol, int vcol, int pt) {
    const int j = pt >> 4, q = pt & 15;
#pragma unroll
    for (int a = 0; a < 5; ++a) R.a[a] = *(const f32x4*)(arr[a] + (size_t)(mrow + j) * 1024 + hcol + 4 * q);
    R.v = *(const f32x4*)(V + (size_t)(mrow + ((pt & 63) >> 2)) * 1024 + vcol + 4 * (pt & 3));
}
__device__ __forceinline__ void scan_write(const ScanRegs& R, LAS unsigned char* buf, int pt) {
    const int j = pt >> 4, q = pt & 15;
#pragma unroll
    for (int a = 0; a < 5; ++a) *(LAS f32x4*)(buf + j * (REC * 4) + a * 256 + q * 16) = R.a[a];
    if (pt < 64) *(LAS f32x4*)(buf + (pt >> 2) * (REC * 4) + 1280 + (pt & 3) * 16) = R.v;
}

#define DECL_PTRS \
    GAS unsigned char* wsg_ = (GAS unsigned char*)p.ws; asm volatile("" : "+s"(wsg_)); unsigned char* ws = (unsigned char*)wsg_;     \
    float* SST = (float*)(ws + WS_SST); float* CHA = (float*)(ws + WS_CHA); float* CHBv = (float*)(ws + WS_CHB); float* CAR = (float*)(ws + WS_CAR); float* LST = (float*)(ws + WS_LST); float* CL = (float*)(ws + WS_CL); \
    bf16* Win_t = (bf16*)(ws + WS_WIN); bf16* Wpa_t = (bf16*)(ws + WS_WPA); bf16* Wpb_t = (bf16*)(ws + WS_WPB); bf16* Wout_t = (bf16*)(ws + WS_WOUT); bf16* Wup_t = (bf16*)(ws + WS_WUP); bf16* Wdn_t = (bf16*)(ws + WS_WDN); \
    bf16* Wlora_t = (bf16*)(ws + WS_WLORA); bf16* Wlru_t = (bf16*)(ws + WS_WLRU); \
    bf16* YA = (bf16*)(ws + WS_YA); bf16* YB = (bf16*)(ws + WS_YB); \
    bf16* XN = (bf16*)(ws + WS_XN); bf16* P = (bf16*)(ws + WS_P); bf16* HALO = (bf16*)(ws + WS_HALO); bf16* LA = (bf16*)(ws + WS_LA); bf16* XC = (bf16*)(ws + WS_XC); \
    bf16* L = (bf16*)(ws + WS_L); float* LRA = (float*)(ws + WS_LRA); bf16* LRB = (bf16*)(ws + WS_LRB); \
    float* SB = (float*)(ws + WS_R); float* Yr = (float*)(ws + WS_Y); \
    bf16* T1 = (bf16*)(ws + WS_T1); bf16* MIX = (bf16*)(ws + WS_MIX); bf16* XN2 = (bf16*)(ws + WS_XN2); bf16* Z = (bf16*)(ws + WS_Z); \
    bf16* GATES = (bf16*)p.out;

#define XB_TMO      128
#define XB_XCNT(j)  (256  + 64 * (j))
#define XB_XSUB(j)  (1280 + 64 * (j))
#define XB_XGEN(j)  (2304 + 64 * (j))
#define XB_TOP      3328
#define XB_TOPGEN   3392
#define XCD_BAR_WORDS 3456
#define XB_SPIN_CAP (1u << 18)

__device__ __forceinline__ unsigned xb_ld(unsigned* p)              { return __hip_atomic_load(p, __ATOMIC_RELAXED, __HIP_MEMORY_SCOPE_AGENT); }
__device__ __forceinline__ unsigned xb_add(unsigned* p, unsigned v) { return __hip_atomic_fetch_add(p, v, __ATOMIC_RELAXED, __HIP_MEMORY_SCOPE_AGENT); }
__device__ __forceinline__ unsigned xb_xcc_id() { return (unsigned)__builtin_amdgcn_s_getreg((3 << 11) | 20) & 0xFu; }
#define XB_SPIN(cond, bar) do { unsigned _sp = 0; while (cond) { __builtin_amdgcn_s_sleep(1); \
    if ((++_sp & 255u) == 0u) { if (xb_ld(&(bar)[XB_TMO])) break; if (_sp > XB_SPIN_CAP) { atomicAdd(&(bar)[XB_TMO], 1u); break; } } } } while (0)

struct XcdBarrier {
    unsigned* bar; unsigned x;
    volatile LAS unsigned* st;
};

__device__ __forceinline__ XcdBarrier xcd_barrier_post(unsigned* bar, volatile LAS unsigned* st) {
    XcdBarrier b; b.bar = bar; b.x = xb_xcc_id(); b.st = st;
    if (threadIdx.x == 0) (void)xb_add(&bar[XB_XCNT(b.x)], 1u);
    return b;
}
__device__ __forceinline__ void xcd_barrier_complete(unsigned* bar, unsigned x, unsigned& nloc, unsigned& nx) {
    const unsigned G = gridDim.x * gridDim.y * gridDim.z;
    unsigned sum, cnt, mine, sp = 0u;
    for (;;) {
        sum = 0u; cnt = 0u; mine = 0u;
#pragma unroll
        for (unsigned j = 0; j < 16; ++j) { const unsigned c = xb_ld(&bar[XB_XCNT(j)]); sum += c; cnt += (c > 0u) ? 1u : 0u; mine = (j == x) ? c : mine; }
        if (sum == G) break;
        __builtin_amdgcn_s_sleep(1);
        if ((++sp & 255u) == 0u) { if (xb_ld(&bar[XB_TMO])) break; if (sp > XB_SPIN_CAP) { atomicAdd(&bar[XB_TMO], 1u); break; } }
    }
    nloc = mine > 0u ? mine : 1u; nx = cnt > 0u ? cnt : 1u;
}

__device__ __forceinline__ void xcd_barrier(const XcdBarrier& b) {
    asm volatile("s_waitcnt vmcnt(0)" ::: "memory");
    __syncthreads();
    if (threadIdx.x == 0) {
        unsigned* bar = b.bar;
        __builtin_amdgcn_s_waitcnt(0);
        unsigned nloc = b.st[0], nx = b.st[1];
        if (nloc == 0u) { xcd_barrier_complete(bar, b.x, nloc, nx); b.st[0] = nloc; b.st[1] = nx; }
        const unsigned old = xb_add(&bar[XB_XSUB(b.x)], 1u);
        const unsigned gen = old / nloc;
        if (old + 1u == (gen + 1u) * nloc) {
            __builtin_amdgcn_fence(__ATOMIC_RELEASE, "agent");
            asm volatile("s_waitcnt vmcnt(0)" ::: "memory");
            const unsigned og = xb_add(&bar[XB_TOP], 1u);
            const unsigned tg = og / nx;
            if (og + 1u == (tg + 1u) * nx) xb_add(&bar[XB_TOPGEN], 1u);
            else XB_SPIN(xb_ld(&bar[XB_TOPGEN]) == tg, bar);
            __builtin_amdgcn_fence(__ATOMIC_ACQUIRE, "agent");
            xb_add(&bar[XB_XGEN(b.x)], 1u);
            asm volatile("s_waitcnt vmcnt(0)" ::: "memory");
        } else {
            XB_SPIN(xb_ld(&bar[XB_XGEN(b.x)]) == gen, bar);
            __builtin_amdgcn_fence(__ATOMIC_ACQUIRE, "agent");
            asm volatile("s_waitcnt vmcnt(0)" ::: "memory");
        }
    }
    __syncthreads();
}

#define LBAR() asm volatile("s_waitcnt lgkmcnt(0)\n\ts_barrier" ::: "memory")
#ifndef PROBE
#define PROBE 0
#endif
#define REP(k) for (int rep_ = 0; rep_ < ((PROBE == (k)) ? 2 : 1); ++rep_)
__global__ void __launch_bounds__(512, 2) fwd_megakernel(Params p) {
    extern __shared__ __attribute__((aligned(16))) unsigned char lds_raw[];
    cg::grid_group grid = cg::this_grid();
    LAS unsigned char* lds = (LAS unsigned char*)lds_raw;
    const int tid = threadIdx.x, lane = tid & 63, wave = __builtin_amdgcn_readfirstlane(tid >> 6);
    const int G = gridDim.x, bid = blockIdx.x, gw = bid * 8 + wave, NGW = G * 8, NGT = G * 512;
#define gtid (bid * 512 + opaque(tid))
    constexpr int HALO_PAR = NB * 3 * PC;

    REP(14) {
        DECL_PTRS
        LAS float* scr = (LAS float*)(lds + wave * 16384);
        const int lane = opaque(tid) & 63;
        constexpr int I_IN = (D / 64) * (NCOL / 32), I_SQ = (D / 64) * (D / 32), I_UP = (D / 64) * (FF / 32), I_DN = (FF / 64) * (D / 32);
        constexpr int NITEMS = I_IN + 3 * I_SQ + I_UP + I_DN;
        for (int it = gw; it < NITEMS; it += NGW) {
            int r = it;
            if (r < I_IN) { transpose_item(p.w_in, D, NCOL, Win_t, scr, r, lane); continue; } r -= I_IN;
            if (r < I_SQ) { transpose_item(p.w_proj_a, D, D, Wpa_t, scr, r, lane); continue; } r -= I_SQ;
            if (r < I_SQ) { transpose_item(p.w_proj_b, D, D, Wpb_t, scr, r, lane); continue; } r -= I_SQ;
            if (r < I_SQ) { transpose_item(p.w_out, D, D, Wout_t, scr, r, lane); continue; } r -= I_SQ;
            if (r < I_UP) { transpose_item(p.w_ff_up, D, FF, Wup_t, scr, r, lane); continue; } r -= I_UP;
            transpose_item(p.w_ff_down, FF, D, Wdn_t, scr, r, lane);
        }
        for (int e = gtid; e < 3072 * 128; e += NGT) {
            const int n = e >> 7, k = e & 127; float v;
            if (n < 1024) v = (k < 64) ? p.w_decay_up[k * 1024 + n] : 0.f;
            else if (n < 2048) v = (k >= 64) ? p.w_aaa_up[(k - 64) * 1024 + (n - 1024)] : 0.f;
            else v = p.w_gate_up[k * 1024 + (n - 2048)];
            Wlora_t[e] = (bf16)f2bf(v);
        }
        for (int e = gtid; e < 2048 * 128; e += NGT) {
            const int n = e >> 7, k = e & 127, pj = n >> 8, nn = n & 255, blk = nn >> 7, gate = (nn >> 6) & 1, j = nn & 63, kb = k >> 6, i = k & 63;
            const float* W = gate ? p.lru_wx : p.lru_wa;
            const float v = (kb == blk) ? W[((2 * pj + blk) * 64 + i) * 64 + j] : 0.f;
            Wlru_t[e] = (bf16)f2bf(v);
        }
        for (int e = gtid; e < HALO_PAR / 2; e += NGT) ((unsigned*)HALO)[e] = 0u;
        for (int e = gtid; e < 256 * 4 * 64 * 4; e += NGT) SST[e] = 0.f;
        for (int e = gtid; e < NB * 1024; e += NGT) LST[e] = 0.f;
        for (int e = gtid; e < 1024; e += NGT) CL[e] = -8.0f * log1pf(__expf(-p.lru_lambda[e]));
        for (int m = gw; m < NB * NMETA; m += NGW) rms_row_to_bf16(p.meta + (size_t)(m & 15) * D, p.norm_mix_g, XN + (size_t)m * D, opaque(tid) & 63);
        for (int e = gtid; e < XCD_BAR_WORDS; e += NGT) __hip_atomic_store((unsigned*)(ws + WS_BAR) + e, 0u, __ATOMIC_RELAXED, __HIP_MEMORY_SCOPE_AGENT);
        if (tid < 16) ((volatile LAS unsigned*)(lds + 131072))[tid] = 0u;
    }
    grid.sync();
    const XcdBarrier xbar = xcd_barrier_post((unsigned*)(p.ws + WS_BAR), (volatile LAS unsigned*)(lds + 131072) + 8);
#define GRID_SYNC() xcd_barrier(xbar)

    for (int s = 0; s < NSEG; ++s) {
        const int lgT = (s == 0) ? 4 : LGSEG, SEGT = 1 << lgT, Mseg = NB * SEGT, Mpad = (s == 0) ? 256 : MSEGMAX, gbase = (s == 0) ? 0 : (s - 1) * SEGMAX, nch = SEGT / CH;
        REP(5) { DECL_PTRS bf16* halo_next = HALO + (size_t)((s + 1) & 1) * HALO_PAR; OpP op{P, halo_next, GATES, Mseg, lgT, gbase, s}; run_gemm<OpP, true>(lds, XN, D, Win_t, Mpad, NCOL, D, 0, 0, op); }
        GRID_SYNC();
        REP(6) { DECL_PTRS const bf16* halo_cur = HALO + (size_t)(s & 1) * HALO_PAR;
        for (int m = gw; m < Mseg; m += NGW) {
            const int lane = opaque(tid) & 63;
            const int b = m >> lgT, i = m & (SEGT - 1);
            const bf16* cur = P + (size_t)m * PC;
            const bf16* pr1 = (i >= 1) ? cur - PC : halo_cur + (size_t)(b * 3 + 2) * PC;
            const bf16* pr2 = (i >= 2) ? cur - 2 * PC : halo_cur + (size_t)(b * 3 + 1 + i) * PC;
            const bf16* pr3 = (i >= 3) ? cur - 3 * PC : halo_cur + (size_t)(b * 3 + i) * PC;
            {
                const int c = 4 * lane; const v2u cw = *(const v2u*)(cur + OFF_WD + c), pw = *(const v2u*)(pr1 + OFF_WD + c); const f32x4 mu = *(const f32x4*)(p.mu + OFF_WD + c);
                float x0 = bflo(cw.x), x1 = bfhi(cw.x), x2 = bflo(cw.y), x3 = bfhi(cw.y);
                x0 += (bflo(pw.x) - x0) * mu.x; x1 += (bfhi(pw.x) - x1) * mu.y; x2 += (bflo(pw.y) - x2) * mu.z; x3 += (bfhi(pw.y) - x3) * mu.w;
                if (lane < 16) { x0 = tanhf_(x0); x1 = tanhf_(x1); x2 = tanhf_(x2); x3 = tanhf_(x3); }
                else if (lane >= 32) { x0 = sigmoidf_(x0); x1 = sigmoidf_(x1); x2 = sigmoidf_(x2); x3 = sigmoidf_(x3); }
                v2u o; o.x = pk2(x0, x1); o.y = pk2(x2, x3); *(v2u*)(LA + (size_t)m * 256 + c) = o;
            }
            {
                const int c = 16 * lane; float x0[16], x1[16], x2[16], x3[16], w[16], o[16];
                load16bf(pr3 + OFF_XB + c, x0); load16bf(pr2 + OFF_XB + c, x1); load16bf(pr1 + OFF_XB + c, x2); load16bf(cur + OFF_XB + c, x3);
                load16f(p.conv_b + c, o);
                load16f(p.conv_w + c, w);
#pragma unroll
                for (int j = 0; j < 16; ++j) o[j] += x0[j] * w[j];
                load16f(p.conv_w + 1024 + c, w);
#pragma unroll
                for (int j = 0; j < 16; ++j) o[j] += x1[j] * w[j];
                load16f(p.conv_w + 2048 + c, w);
#pragma unroll
                for (int j = 0; j < 16; ++j) o[j] += x2[j] * w[j];
                load16f(p.conv_w + 3072 + c, w);
#pragma unroll
                for (int j = 0; j < 16; ++j) o[j] += x3[j] * w[j];
                store16bf(XC + (size_t)m * 1024 + c, o);
            }
        } }
        GRID_SYNC();
        REP(7) { DECL_PTRS OpLora op{L, Mseg}; run_gemm<OpLora, true>(lds, LA, 256, Wlora_t, Mpad, 3072, 128, 3, 128, op); }
        REP(7) { DECL_PTRS OpLru op{LRA, LRB, XC, CL, p.lru_ba, p.lru_bx, Mseg}; run_gemm<OpLru, true>(lds, XC, 1024, Wlru_t, Mpad, 2048, 128, 0, 128, op); }
        GRID_SYNC();
        REP(3) { DECL_PTRS const bf16* halo_cur = HALO + (size_t)(s & 1) * HALO_PAR;
        const int lch = (SEGT < 32) ? SEGT : 32, nlc = SEGT / lch;
        const bool lru_bg = (s >= 1) && (G == 256) && (SEGT == 2048);
        if (!lru_bg)
        for (int idx = gtid; idx < NB * nlc * 512; idx += NGT) {
            const int c = 2 * (idx & 511), q = idx >> 9, chunk = q % nlc, b = q / nlc; const size_t m0 = (size_t)b * SEGT + chunk * lch;
            f32x2 ap = {1.f, 1.f}, bacc = {0.f, 0.f};
#pragma unroll 32
            for (int j = 0; j < lch; ++j) { const f32x2 a = *(const f32x2*)(LRA + (m0 + j) * 1024 + c); const unsigned lb = *(const unsigned*)(LRB + (m0 + j) * 1024 + c);
                const f32x2 bb = {sqrtf_(fmaxf(1.0f - a.x * a.x, 0.f)) * bflo(lb), sqrtf_(fmaxf(1.0f - a.y * a.y, 0.f)) * bfhi(lb)}; bacc = a * bacc + bb; ap = ap * a; }
            *(f32x2*)(CHA + (size_t)(b * 64 + chunk) * 1024 + c) = ap; *(f32x2*)(CHBv + (size_t)(b * 64 + chunk) * 1024 + c) = bacc;
        }
        const int nch = (SEGT + CH - 1) / CH;
        for (int u = bid; u < 256; u += G) {
            const int tq = opaque(tid), lane = tq & 63;
            const int bh = (u & 7) * 8 + ((u >> 3) >> 2), rg = (u >> 3) & 3, b = bh >> 4, h = bh & 15, mrow0 = b * SEGT, hcol = h * 64, vcol = hcol + rg * 16;
            __syncthreads();
            if (wave >= 4) {
                const int pt = tq - 256, pj = pt >> 4, pq = pt & 15, pc = hcol + 4 * pq;
                const f32x4 mu_r = *(const f32x4*)(p.mu + pc), mu_k = *(const f32x4*)(p.mu + 1024 + pc), mu_v = *(const f32x4*)(p.mu + 2048 + pc), c_w0 = *(const f32x4*)(p.w0 + pc), c_a0 = *(const f32x4*)(p.a0 + pc),
                            c_kk = *(const f32x4*)(p.k_k + pc), c_ka = *(const f32x4*)(p.k_a + pc), c_rk = *(const f32x4*)(p.r_k + pc);
                const bf16* halo_b = halo_cur + (size_t)(b * 3 + 2) * PC;
#define PREP_DECL(X) v2u X##rc, X##rp, X##kc, X##kp, X##vc, X##vp, X##ld, X##la
                PREP_DECL(A0); PREP_DECL(A1); PREP_DECL(B0); PREP_DECL(B1);
#define PREP_LOAD(X, cc, toff) { const int tj_ = (cc) * CH + pj + (toff); const bf16* cur_ = P + (size_t)(mrow0 + tj_) * PC; const bf16* prv_ = (tj_ >= 1) ? cur_ - PC : halo_b; \
                X##rc = *(const v2u*)(cur_ + pc); X##rp = *(const v2u*)(prv_ + pc); X##kc = *(const v2u*)(cur_ + 1024 + pc); X##kp = *(const v2u*)(prv_ + 1024 + pc); X##vc = *(const v2u*)(cur_ + 2048 + pc); X##vp = *(const v2u*)(prv_ + 2048 + pc); \
                const bf16* l_ = L + (size_t)(mrow0 + tj_) * 3072 + pc; X##ld = *(const v2u*)l_; X##la = *(const v2u*)(l_ + 1024); }
#define SHIFT4(C, Q, MU) ((f32x4){bflo(C.x) + (bflo(Q.x) - bflo(C.x)) * MU.x, bfhi(C.x) + (bfhi(Q.x) - bfhi(C.x)) * MU.y, bflo(C.y) + (bflo(Q.y) - bflo(C.y)) * MU.z, bfhi(C.y) + (bfhi(Q.y) - bfhi(C.y)) * MU.w})
#define PREP_CW(X, cc, bufp, toff) { const int tj_ = (cc) * CH + pj + (toff); LAS unsigned char* rec_ = (bufp) + (pj + (toff)) * (REC * 4); const bool ok_ = tj_ < SEGT; \
                const f32x4 r_ = SHIFT4(X##rc, X##rp, mu_r), k_ = SHIFT4(X##kc, X##kp, mu_k), v_ = SHIFT4(X##vc, X##vp, mu_v); \
                f32x4 w_, a_; w_.x = __expf(-0.6065306597126334f * sigmoidf_(c_w0.x + bflo(X##ld.x))); w_.y = __expf(-0.6065306597126334f * sigmoidf_(c_w0.y + bfhi(X##ld.x))); w_.z = __expf(-0.6065306597126334f * sigmoidf_(c_w0.z + bflo(X##ld.y))); w_.w = __expf(-0.6065306597126334f * sigmoidf_(c_w0.w + bfhi(X##ld.y))); \
                a_.x = sigmoidf_(c_a0.x + bflo(X##la.x)); a_.y = sigmoidf_(c_a0.y + bfhi(X##la.x)); a_.z = sigmoidf_(c_a0.z + bflo(X##la.y)); a_.w = sigmoidf_(c_a0.w + bfhi(X##la.y)); \
                f32x4 q_ = k_ * c_kk; const float ss_ = red16((q_.x * q_.x + q_.y * q_.y) + (q_.z * q_.z + q_.w * q_.w)); q_ = q_ * rsqf_(fmaxf(ss_, 1e-24f)); \
                f32x4 km_ = k_ * (1.0f + (a_ - 1.0f) * c_ka), bb_ = q_ * a_; \
                const f32x4 rk_ = r_ * km_ * c_rk; const float sb_ = red16((rk_.x + rk_.y) + (rk_.z + rk_.w)); \
                if (rg == 0 && pq == 0 && ok_) SB[(size_t)(mrow0 + tj_) * 16 + h] = sb_; \
                if (!ok_) { w_ = (f32x4){1.f, 1.f, 1.f, 1.f}; km_ = (f32x4){0.f, 0.f, 0.f, 0.f}; bb_ = km_; q_ = km_; }     \
                *(LAS f32x4*)(rec_ + pq * 16) = ok_ ? r_ : (f32x4){0.f, 0.f, 0.f, 0.f}; *(LAS f32x4*)(rec_ + 256 + pq * 16) = w_; *(LAS f32x4*)(rec_ + 512 + pq * 16) = km_; *(LAS f32x4*)(rec_ + 768 + pq * 16) = q_; *(LAS f32x4*)(rec_ + 1024 + pq * 16) = bb_; \
                if ((pq >> 2) == rg) *(LAS f32x4*)(rec_ + 1280 + (pq & 3) * 16) = ok_ ? v_ : (f32x4){0.f, 0.f, 0.f, 0.f}; }
#define CLAMPC(x) (((x) < nch) ? (x) : nch - 1)
                PREP_LOAD(A0, 0, 0); PREP_LOAD(A1, 0, 16); PREP_LOAD(B0, CLAMPC(1), 0); PREP_LOAD(B1, CLAMPC(1), 16);
                PREP_CW(A0, 0, lds, 0); PREP_CW(A1, 0, lds, 16); PREP_LOAD(A0, CLAMPC(2), 0); PREP_LOAD(A1, CLAMPC(2), 16);
                const float one_ = __builtin_bit_cast(float, opaque(0x3f800000)), zero_ = __builtin_bit_cast(float, opaque(0));
                f32x2 l_ap = {one_, one_}, l_b = {zero_, zero_};
                for (int c = 0; c < nch; c += 2) {
                    LBAR();
                    if (c + 1 < nch) { PREP_CW(B0, c + 1, lds + CHBYTES, 0); PREP_CW(B1, c + 1, lds + CHBYTES, 16); PREP_LOAD(B0, CLAMPC(c + 3), 0); PREP_LOAD(B1, CLAMPC(c + 3), 16); }
                    const bool dolru = lru_bg && (u == bid) && ((c & 7) == 4);
                    const int lsel = c >> 3, lidx = bid * 512 + pt + 256 * (lsel >> 2), lhb = lsel & 3;
                    const int lc = 2 * (lidx & 511), lq = lidx >> 9, lchunk = lq & 63, lb2 = lq >> 6; const size_t lm0 = (size_t)lb2 * SEGT + lchunk * 32 + lhb * 8;
                    f32x2 la[8]; unsigned lbv[8];
                    if (dolru) {
#pragma unroll
                        for (int j = 0; j < 8; ++j) { la[j] = *(const f32x2*)(LRA + (lm0 + j) * 1024 + lc); lbv[j] = *(const unsigned*)(LRB + (lm0 + j) * 1024 + lc); }
                    } else {
#pragma unroll
                        for (int j = 0; j < 8; ++j) { la[j] = (f32x2){zero_, zero_}; lbv[j] = 0u; }
                    }
                    const int xrow = (bid * 4 + (wave - 4)) + (c >> 2) * (G * 4); const bool doxn = lru_bg && (s + 1 < NSEG) && (u == bid) && ((c & 3) == 2) && (xrow < MSEGMAX);
                    f32x4 xv0, xv1, xv2, xv3;
                    if (doxn) { const float* xsrc = p.x + ((size_t)(xrow >> LGSEG) * SEQ + (size_t)s * SEGMAX + (xrow & (SEGMAX - 1))) * D;
                        xv0 = *((const f32x4*)xsrc + lane); xv1 = *((const f32x4*)xsrc + lane + 64); xv2 = *((const f32x4*)xsrc + lane + 128); xv3 = *((const f32x4*)xsrc + lane + 192); }
                    else { xv0 = (f32x4){zero_, zero_, zero_, zero_}; xv1 = xv0; xv2 = xv0; xv3 = xv0; }
                    if (c + 1 >= nch) break;
                    LBAR();
                    if (c + 2 < nch) { PREP_CW(A0, c + 2, lds, 0); PREP_CW(A1, c + 2, lds, 16); PREP_LOAD(A0, CLAMPC(c + 4), 0); PREP_LOAD(A1, CLAMPC(c + 4), 16); }
                    if (doxn) {
                        float sq = (xv0.x * xv0.x + xv0.y * xv0.y) + (xv0.z * xv0.z + xv0.w * xv0.w) + (xv1.x * xv1.x + xv1.y * xv1.y) + (xv1.z * xv1.z + xv1.w * xv1.w)
                                 + (xv2.x * xv2.x + xv2.y * xv2.y) + (xv2.z * xv2.z + xv2.w * xv2.w) + (xv3.x * xv3.x + xv3.y * xv3.y) + (xv3.z * xv3.z + xv3.w * xv3.w);
                        const float sc = rsqf_(wave_sum(sq) * (1.f / D) + RMS_EPS);
                        v2u* od = (v2u*)(XN + (size_t)xrow * D) + lane; const f32x4* gp = (const f32x4*)p.norm_mix_g + lane;
                        { const f32x4 gg = gp[0]; v2u o; o.x = pk2(xv0.x * sc * gg.x, xv0.y * sc * gg.y); o.y = pk2(xv0.z * sc * gg.z, xv0.w * sc * gg.w); od[0] = o; }
                        { const f32x4 gg = gp[64]; v2u o; o.x = pk2(xv1.x * sc * gg.x, xv1.y * sc * gg.y); o.y = pk2(xv1.z * sc * gg.z, xv1.w * sc * gg.w); od[64] = o; }
                        { const f32x4 gg = gp[128]; v2u o; o.x = pk2(xv2.x * sc * gg.x, xv2.y * sc * gg.y); o.y = pk2(xv2.z * sc * gg.z, xv2.w * sc * gg.w); od[128] = o; }
                        { const f32x4 gg = gp[192]; v2u o; o.x = pk2(xv3.x * sc * gg.x, xv3.y * sc * gg.y); o.y = pk2(xv3.z * sc * gg.z, xv3.w * sc * gg.w); od[192] = o; }
                    }
                    if (dolru) {
                        if (lhb == 0) { l_ap = (f32x2){one_, one_}; l_b = (f32x2){zero_, zero_}; }
#pragma unroll
                        for (int j = 0; j < 8; ++j) { const f32x2 a = la[j]; const f32x2 bb = {sqrtf_(fmaxf(1.0f - a.x * a.x, 0.f)) * bflo(lbv[j]), sqrtf_(fmaxf(1.0f - a.y * a.y, 0.f)) * bfhi(lbv[j])}; l_b = a * l_b + bb; l_ap = l_ap * a; }
                        if (lhb == 3) { *(f32x2*)(CHA + (size_t)(lb2 * 64 + lchunk) * 1024 + lc) = l_ap; *(f32x2*)(CHBv + (size_t)(lb2 * 64 + lchunk) * 1024 + lc) = l_b; }
                    }
                }
#undef PREP_DECL
#undef PREP_LOAD
#undef PREP_CW
#undef SHIFT4
#undef CLAMPC
            } else {
                const int g4 = lane >> 4, kq = lane & 15;
                float* sst = SST + ((size_t)(u * 4 + wave) * 64 + lane) * 4;
                f32x2 S01, S23; { const f32x4 S = *(const f32x4*)sst; S01 = (f32x2){S.x, S.y}; S23 = (f32x2){S.z, S.w}; }
                const int ycol = vcol + wave * 4 + g4;
                const int lo = kq * 16, vo = 1280 + (wave * 4 + g4) * 4;
#define SC_DECL(X) f32x4 X##r, X##w, X##k, X##q, X##b; float X##v
#define SC_LD(X, j) { const LAS unsigned char* rec_ = buf + (j) * (REC * 4); X##r = *(const LAS f32x4*)(rec_ + lo); X##w = *(const LAS f32x4*)(rec_ + 256 + lo); X##k = *(const LAS f32x4*)(rec_ + 512 + lo); \
                      X##q = *(const LAS f32x4*)(rec_ + 768 + lo); X##b = *(const LAS f32x4*)(rec_ + 1024 + lo); X##v = *(const LAS float*)(rec_ + vo); }
#define SC_CP(X, Y) { X##r = Y##r; X##w = Y##w; X##k = Y##k; X##q = Y##q; X##b = Y##b; X##v = Y##v; }
#define LO2(v) ((f32x2){(v).x, (v).y})
#define HI2(v) ((f32x2){(v).z, (v).w})
#define SC_STEP(X, j) { f32x2 ta = S01 * LO2(X##q); ta = S23 * HI2(X##q) + ta; f32x2 tb = S01 * LO2(Pr); tb = S23 * HI2(Pr) + tb; \
                        float sa = ta.x + ta.y, yy = tb.x + tb.y; const f32x2 kv01 = LO2(X##k) * X##v, kv23 = HI2(X##k) * X##v; \
                        sa += dppf(sa, 0); yy += dppf(yy, 0); sa += dppf(sa, 1); yy += dppf(yy, 1); sa += dppf(sa, 2); yy += dppf(yy, 2); sa += dppf(sa, 3); yy += dppf(yy, 3); \
                        if ((j) > 0 && (j) <= 16) yk0 = (kq == (j) - 1) ? yy : yk0; if ((j) > 16) yk1 = (kq == (j) - 17) ? yy : yk1; \
                        S01 = S01 * LO2(X##w) + (kv01 - LO2(X##b) * sa); S23 = S23 * HI2(X##w) + (kv23 - HI2(X##b) * sa); Pr = X##r; }
                for (int c = 0; c < nch; ++c) {
                    LBAR();
                    const LAS unsigned char* buf = lds + (c & 1) * CHBYTES;
                    float yk0 = 0.f, yk1 = 0.f; f32x4 Pr;
                    SC_DECL(C0); SC_DECL(N0);
                    SC_LD(C0, 0);
                    SC_CP(N0, C0); Pr = C0r;
#pragma unroll
                    for (int j = 0; j < CH; ++j) {
                        if (j + 1 < CH) SC_LD(N0, j + 1);
                        SC_STEP(C0, j);
                        SC_CP(C0, N0);
                    }
                    { f32x2 tb = S01 * LO2(Pr); tb = S23 * HI2(Pr) + tb; const float yy = red16(tb.x + tb.y); yk1 = (kq == 15) ? yy : yk1; }
                    const int t0c = c * CH + kq;
                    if (t0c < SEGT) Yr[(size_t)(mrow0 + t0c) * 1024 + ycol] = yk0;
                    if (t0c + 16 < SEGT) Yr[(size_t)(mrow0 + t0c + 16) * 1024 + ycol] = yk1;
                }
#undef SC_DECL
#undef SC_LD
#undef SC_CP
#undef SC_STEP
#undef LO2
#undef HI2
                if (PROBE != 3 || rep_ == 1) *(f32x4*)sst = (f32x4){S01.x, S01.y, S23.x, S23.y};
            }
        } }
        GRID_SYNC();
        REP(4) { DECL_PTRS const bf16* halo_cur = HALO + (size_t)(s & 1) * HALO_PAR;
        if (s > 0) {
            for (int m = gw; m < Mseg; m += NGW) {
                const int lane = opaque(tid) & 63;
                const int b = m >> lgT, i = m & (SEGT - 1), c = 16 * lane; const size_t o = (size_t)m * 1024 + c;
                const bf16* cur = P + (size_t)m * PC; const bf16* pr1 = (i >= 1) ? cur - PC : halo_cur + (size_t)(b * 3 + 2) * PC;
                float y[16], t[16], u[16];
                load16f(Yr + o, y); float sm = 0.f;
#pragma unroll
                for (int j = 0; j < 16; ++j) sm += y[j];
                const float mean = quad_sum(sm) * (1.f / 64.f); float vs = 0.f;
#pragma unroll
                for (int j = 0; j < 16; ++j) { y[j] -= mean; vs += y[j] * y[j]; }
                const float rstd = rsqf_(quad_sum(vs) * (1.f / 64.f) + LNX_EPS);
                load16f(p.ln_w + c, t); load16f(p.ln_b + c, u);
#pragma unroll
                for (int j = 0; j < 16; ++j) y[j] = y[j] * rstd * t[j] + u[j];
                const float bs = SB[(size_t)m * 16 + (lane >> 2)];
                shift16(cur + 2048 + c, pr1 + 2048 + c, p.mu + 2048 + c, t); load16bf(L + (size_t)m * 3072 + 2048 + c, u);
#pragma unroll
                for (int j = 0; j < 16; ++j) y[j] = (y[j] + bs * t[j]) * u[j];
                store16bf(YA + ((size_t)b * SEQ + gbase + i) * 1024 + c, y);
            }
        }
        {
            const int lch = (SEGT < 32) ? SEGT : 32, nlc = SEGT / lch;
            const float* LSTin = LST + (size_t)(s & 1) * (NB * 1024); float* LSTout = LST + (size_t)((s + 1) & 1) * (NB * 1024);
            for (int idx = gtid; idx < NB * nlc * 512; idx += NGT) {
                const int c = 2 * (idx & 511), q = idx >> 9, chunk = q % nlc, b = q / nlc; const size_t m0 = (size_t)b * SEGT + chunk * lch;
                f32x2 hh = *(const f32x2*)(LSTin + b * 1024 + c);
#pragma unroll 16
                for (int k = 0; k < chunk; ++k) { const size_t o = (size_t)(b * 64 + k) * 1024 + c; hh = *(const f32x2*)(CHA + o) * hh + *(const f32x2*)(CHBv + o); }
#pragma unroll 32
                for (int j = 0; j < lch; ++j) {
                    const f32x2 a = *(const f32x2*)(LRA + (m0 + j) * 1024 + c); const unsigned lb = *(const unsigned*)(LRB + (m0 + j) * 1024 + c);
                    const f32x2 bb = {sqrtf_(fmaxf(1.0f - a.x * a.x, 0.f)) * bflo(lb), sqrtf_(fmaxf(1.0f - a.y * a.y, 0.f)) * bfhi(lb)}; hh = a * hh + bb;
                    if (s > 0) { const unsigned yb = *(const unsigned*)(P + (m0 + j) * PC + OFF_YB + c);
                        *(unsigned*)(YB + ((size_t)b * SEQ + gbase + chunk * lch + j) * 1024 + c) = pk2(hh.x * gelu_tanh(bflo(yb)), hh.y * gelu_tanh(bfhi(yb))); }
                }
                if (chunk == nlc - 1 && (PROBE != 4 || rep_ == 1)) *(f32x2*)(LSTout + b * 1024 + c) = hh;
            }
        }
        if (s + 1 < NSEG && !((s >= 1) && (G == 256) && (SEGT == 2048))) {
            for (int m = gw; m < MSEGMAX; m += 4 * NGW) {
                int mr[4]; const float* xr[4]; bf16* orow[4];
#pragma unroll
                for (int r = 0; r < 4; ++r) { mr[r] = (m + r * NGW < MSEGMAX) ? m + r * NGW : m; const int b = mr[r] >> LGSEG, i = mr[r] & (SEGMAX - 1); xr[r] = p.x + ((size_t)b * SEQ + (size_t)s * SEGMAX + i) * D; orow[r] = XN + (size_t)mr[r] * D; }
                rms_rows4_to_bf16(xr[0], xr[1], xr[2], xr[3], p.norm_mix_g, orow[0], orow[1], orow[2], orow[3], opaque(tid) & 63);
            }
        } }
        GRID_SYNC();
    }

    REP(10) { DECL_PTRS OpT1 op{T1, GATES}; run_gemm<OpT1, true>(lds, YA, D, Wpa_t, MT, D, D, 0, 0, op); }
    REP(10) { DECL_PTRS OpMix op{T1, GATES, MIX}; run_gemm<OpMix, true>(lds, YB, D, Wpb_t, MT, D, D, 0, 0, op); }
    { DECL_PTRS const int st_ = opaque(NGT); for (int e = gtid; e < MT; e += st_) CAR[e] = 0.f; }
    GRID_SYNC();
    REP(11) { DECL_PTRS OpH1 op{p.x, p.out, p.norm_ffn_g, XN2, CAR}; run_gemm<OpH1, true>(lds, MIX, D, Wout_t, MT, D, D, 0, 0, op); }
    GRID_SYNC();
    REP(13) { DECL_PTRS OpZ op{Z, CAR}; run_gemm<OpZ, true>(lds, XN2, D, Wup_t, MT, FF, D, 0, 0, op); }
    GRID_SYNC();
    { DECL_PTRS OpAcc op{p.out}; run_gemm<OpAcc, true>(lds, Z, FF, Wdn_t, MT, D, FF, 0, 0, op); }
    GRID_SYNC();
    for (int m = gw; m < MT; m += 4 * NGW) {
        const int lane = opaque(tid) & 63;
        float* rows[4]; f32x4 v[4][4];
#pragma unroll
        for (int r = 0; r < 4; ++r) { const int mr = (m + r * NGW < MT) ? m + r * NGW : m; rows[r] = p.out + (size_t)mr * D;
#pragma unroll
            for (int j = 0; j < 4; ++j) v[r][j] = *((const f32x4*)rows[r] + lane + 64 * j); }
        f32x4 gg[4];
#pragma unroll
        for (int j = 0; j < 4; ++j) gg[j] = *((const f32x4*)p.norm_final_g + lane + 64 * j);
#pragma unroll
        for (int r = 0; r < 4; ++r) {
            float sq = 0.f;
#pragma unroll
            for (int j = 0; j < 4; ++j) sq += (v[r][j].x * v[r][j].x + v[r][j].y * v[r][j].y) + (v[r][j].z * v[r][j].z + v[r][j].w * v[r][j].w);
            const float sc = rsqf_(wave_sum(sq) * (1.f / D) + RMS_EPS);
            if (r == 0 || m + r * NGW < MT) {
#pragma unroll
                for (int j = 0; j < 4; ++j) *((f32x4*)rows[r] + lane + 64 * j) = v[r][j] * sc * gg[j];
            }
        }
    }
    if (PROBE == 1) { for (int i = 0; i < 40; ++i) GRID_SYNC(); }
}

extern "C" void kernel_launch(void* const* d_in, const int* in_sizes, int n_in, void* d_out, int out_size, void* d_ws, size_t ws_size, hipStream_t stream) {
    static int grid_blocks = 0;
    if (grid_blocks == 0) {
        if (n_in != 29 || ws_size < WS_TAIL_END) { fprintf(stderr, "kernel_launch: unexpected n_in %d or ws_size %zu (< %zu)\n", n_in, ws_size, (size_t)WS_END); grid_blocks = -1; return; }
        int dev = 0, cus = 0, per_cu = 0;
        hipGetDevice(&dev);
        hipDeviceGetAttribute(&cus, hipDeviceAttributeMultiprocessorCount, dev);
        hipFuncSetAttribute((const void*)fwd_megakernel, hipFuncAttributeMaxDynamicSharedMemorySize, LDS_BYTES);
        hipOccupancyMaxActiveBlocksPerMultiprocessor(&per_cu, (const void*)fwd_megakernel, 512, LDS_BYTES);
        if (per_cu < 1) per_cu = 1;
        grid_blocks = cus * per_cu;
        (void)hipGetLastError();
    }
    if (grid_blocks < 0) return;
    Params p{};
    const float** f = (const float**)&p;
    for (int i = 0; i < 29; ++i) f[i] = (const float*)d_in[i];
    p.out = (float*)d_out; p.ws = (unsigned char*)d_ws;
    void* args[] = {&p};
    hipError_t e = hipLaunchCooperativeKernel((const void*)fwd_megakernel, dim3(grid_blocks), dim3(512), args, LDS_BYTES, stream);
    if (e != hipSuccess) fprintf(stderr, "cooperative launch failed: %s (grid %d)\n", hipGetErrorString(e), grid_blocks);
}
```

```cpp
#include <hip/hip_runtime.h>
#include <hip/hip_cooperative_groups.h>
#include <cstdio>
#include <cstdint>
namespace cg = cooperative_groups;

#define GAS __attribute__((address_space(1)))
#define LAS __attribute__((address_space(3)))
typedef unsigned short bf16;
typedef unsigned v4u __attribute__((ext_vector_type(4)));
typedef unsigned v2u __attribute__((ext_vector_type(2)));
typedef float f32x4 __attribute__((ext_vector_type(4)));
typedef float f32x2 __attribute__((ext_vector_type(2)));
typedef short bf16x8 __attribute__((ext_vector_type(8)));

namespace pg8 {
constexpr int BM = 256, BK = 64, HALF = 128, HTB = HALF * BK * 2, STAGE_BYTES = 8 * HTB, NXCD = 8, WGM = 8;
__host__ __device__ __forceinline__ int lds_byte(int r, int c) { const int st = (r >> 4) * 2 + (c >> 5), rr = r & 15, cc = c & 31, ob = rr * 64 + cc * 2; return st * 1024 + (ob ^ (((ob >> 9) & 1) << 5)); }
__host__ __device__ __forceinline__ void stage_rc(int b, int& R, int& C) { const int st = b / 1024, sb = b % 1024, swz = sb ^ (((sb >> 9) & 1) << 5); R = (st >> 1) * 16 + swz / 64; C = (st & 1) * 32 + (swz % 64) / 2; }
__host__ __device__ __forceinline__ int perm32(int rho) { const int n = rho >> 4, i = rho & 15; return 8 * (i >> 2) + 4 * n + (i & 3); }
struct Unit { int pm, pn; };
struct Gemm { const bf16* A; const bf16* Bt; int M, N, K, lda, ash, amul; };
struct StaticOrder {
    int nM, nN, nwg, G, c;
    __host__ __device__ void init(int M, int N, int G_, int c_) { nM = M / BM; nN = N / BM; nwg = nM * nN; G = G_; c = c_; }
    __host__ __device__ bool next(int i, Unit& u) const {
        const long L = (long)i * G + c; if (L >= nwg) return false;
        int wgid = (int)L; { const int q = nwg / NXCD, r = nwg % NXCD, xcd = wgid % NXCD, off = wgid / NXCD; wgid = (xcd < r ? xcd * (q + 1) : r * (q + 1) + (xcd - r) * q) + off; }
        const int nig = WGM * nN, gid = wgid / nig, fm = gid * WGM, gsz = (nM - fm) < WGM ? (nM - fm) : WGM;
        u.pm = fm + ((wgid % nig) % gsz); u.pn = (wgid % nig) / gsz; return true;
    }
};
template <class Op> struct EpiOp {
    static constexpr bool PERM = true;
    Op op;
    __device__ __forceinline__ void operator()(const f32x4 (&acc)[2][2][4][2], const Unit& u, int wr, int wc, int fr, int fq) const {
        int row0 = u.pm * BM + wr * 64 + fr, col0 = u.pn * BM + wc * 32 + 8 * fq;
        asm volatile("" : "+v"(row0), "+v"(col0));
#pragma unroll
        for (int ai = 0; ai < 2; ++ai)
#pragma unroll
            for (int m = 0; m < 4; ++m)
                { op(row0 + ai * HALF + m * 16, col0, acc[ai][0][m][0], acc[ai][0][m][1]); op(row0 + ai * HALF + m * 16, col0 + HALF, acc[ai][1][m][0], acc[ai][1][m][1]); asm volatile("" ::: "memory"); }
    }
};

template <class Epi, class Sched, bool ALIGN_EPI>
__device__ __forceinline__ void gemm_phase(LAS unsigned char* lds, const Gemm g, const Sched& S, const Epi& E) {
    int tid = threadIdx.x; asm volatile("" : "+v"(tid));
    const int wid = __builtin_amdgcn_readfirstlane(tid >> 6), lane = tid & 63, wr = wid >> 2, wc = wid & 3, fr = lane & 15, fq = lane >> 4;
    const int K = g.K, nt = K / BK;
    unsigned voffA[2], voffB[2];
#pragma unroll
    for (int i = 0; i < 2; ++i) { int R, C; stage_rc(tid * 16 + i * 8192, R, C); const int Rb = Epi::PERM ? ((R & ~31) + perm32(R & 31)) : R;
        voffA[i] = (unsigned)(R * g.lda + C) * 2u; voffB[i] = (unsigned)(Rb * K + C) * 2u; }
    const size_t kstep = (size_t)(BK * 2);
    const size_t hstepA = (size_t)HALF * g.lda * 2, hstepB = (size_t)HALF * K * 2;
    const size_t tstepA = 2 * hstepA, tstepB = 2 * hstepB;
    const unsigned ldsw = (unsigned)wid * 1024u;
    const int aoff = lds_byte(wr * 64 + fr, fq * 8), boff = lds_byte(wc * 32 + fr, fq * 8);
#define PG8_SA(b, h) (((b) * 2 + (h)) * HTB)
#define PG8_SB(b, h) ((4 + (b) * 2 + (h)) * HTB)
#define PG8_STAGE(bufoff, gbase, voff) do { _Pragma("unroll") for (int _i = 0; _i < 2; ++_i) \
        __builtin_amdgcn_global_load_lds((const unsigned*)((const char*)(gbase) + (voff)[_i]), (LAS unsigned*)(lds + (bufoff) + ldsw + _i * 8192), 16, 0, 0); } while (0)
#define PG8_LDA(dst, b, h) do { _Pragma("unroll") for (int m = 0; m < 4; ++m) _Pragma("unroll") for (int k = 0; k < 2; ++k) dst[m][k] = *(const LAS bf16x8*)(lds + PG8_SA(b, h) + aoff + m * 2048 + k * 1024); } while (0)
#define PG8_LDB(dst, b, h) do { _Pragma("unroll") for (int n = 0; n < 2; ++n) _Pragma("unroll") for (int k = 0; k < 2; ++k) dst[n][k] = *(const LAS bf16x8*)(lds + PG8_SB(b, h) + boff + n * 2048 + k * 1024); } while (0)
#define PG8_MMA(ai, bj, At, Bt) do { __builtin_amdgcn_s_setprio(1); _Pragma("unroll") for (int m = 0; m < 4; ++m) _Pragma("unroll") for (int n = 0; n < 2; ++n) _Pragma("unroll") for (int k = 0; k < 2; ++k) \
        acc[ai][bj][m][n] = __builtin_amdgcn_mfma_f32_16x16x32_bf16(Bt[n][k], At[m][k], acc[ai][bj][m][n], 0, 0, 0); __builtin_amdgcn_s_setprio(0); } while (0)
#define PG8_WAIT_V(n) asm volatile("s_waitcnt vmcnt(" #n ")" ::: "memory")
#define PG8_WAIT_L(n) asm volatile("s_waitcnt lgkmcnt(" #n ")" ::: "memory")
#define PG8_BAR __builtin_amdgcn_s_barrier()
#define PG8_SCHED __builtin_amdgcn_sched_barrier(0)
#define PG8_UA(u) ((const char*)g.A + (size_t)(u).pm * tstepA + (size_t)(((u).pn >> g.ash) * g.amul) * 2)
#define PG8_UB(u) ((const char*)g.Bt + (size_t)(u).pn * tstepB)
    Unit cur, nxt; int ui = 0;
    if (!S.next(0, cur)) return;
    f32x4 acc[2][2][4][2];
#pragma unroll
    for (int a = 0; a < 2; ++a)
#pragma unroll
        for (int b = 0; b < 2; ++b)
#pragma unroll
            for (int m = 0; m < 4; ++m)
#pragma unroll
                for (int n = 0; n < 2; ++n) acc[a][b][m][n] = (f32x4){0.f, 0.f, 0.f, 0.f};
    bf16x8 At[4][2], B0[2][2], B1[2][2];
    const char* cA = PG8_UA(cur); const char* cB = PG8_UB(cur);
    PG8_STAGE(PG8_SB(0, 0), cB, voffB); PG8_STAGE(PG8_SB(0, 1), cB + hstepB, voffB); PG8_STAGE(PG8_SA(0, 0), cA, voffA); PG8_STAGE(PG8_SA(0, 1), cA + hstepA, voffA);
    if (wr == 1) PG8_BAR;
    PG8_WAIT_V(2); PG8_BAR;
    PG8_STAGE(PG8_SB(1, 0), cB + kstep, voffB); PG8_STAGE(PG8_SA(1, 0), cA + kstep, voffA); PG8_STAGE(PG8_SB(1, 1), cB + hstepB + kstep, voffB);
    PG8_WAIT_V(6); PG8_BAR;
    for (;;) {
        const bool has_next = S.next(ui + 1, nxt);
        const char* nA = has_next ? PG8_UA(nxt) : cA; const char* nB = has_next ? PG8_UB(nxt) : cB;
        for (int t = 0; t < nt; t += 2) {
            const bool last = (t == nt - 2);
            const char* a1 = cA + (size_t)(t + 1) * kstep;
            const char* a2 = last ? nA : cA + (size_t)(t + 2) * kstep; const char* b2 = last ? nB : cB + (size_t)(t + 2) * kstep;
            const char* a3 = a2 + kstep; const char* b3 = b2 + kstep;
            PG8_LDB(B0, 0, 0); PG8_LDB(B1, 0, 1); PG8_SCHED; PG8_LDA(At, 0, 0); PG8_STAGE(PG8_SA(1, 1), a1 + hstepA, voffA);
            PG8_WAIT_V(8); PG8_WAIT_L(0); PG8_BAR; PG8_MMA(0, 0, At, B0); PG8_MMA(0, 1, At, B1); PG8_BAR; PG8_SCHED;
            PG8_LDA(At, 0, 1); PG8_STAGE(PG8_SB(0, 0), b2, voffB); PG8_STAGE(PG8_SB(0, 1), b2 + hstepB, voffB); PG8_STAGE(PG8_SA(0, 0), a2, voffA);
            PG8_WAIT_V(8); PG8_WAIT_L(0); PG8_BAR; PG8_MMA(1, 0, At, B0); PG8_MMA(1, 1, At, B1); PG8_BAR; PG8_SCHED;
            PG8_LDB(B0, 1, 0); PG8_LDB(B1, 1, 1); PG8_SCHED; PG8_LDA(At, 1, 0); PG8_STAGE(PG8_SA(0, 1), a2 + hstepA, voffA);
            PG8_WAIT_V(8); PG8_WAIT_L(0); PG8_BAR; PG8_MMA(0, 0, At, B0); PG8_MMA(0, 1, At, B1); PG8_BAR; PG8_SCHED;
            PG8_LDA(At, 1, 1); PG8_STAGE(PG8_SB(1, 0), b3, voffB); PG8_STAGE(PG8_SB(1, 1), b3 + hstepB, voffB); PG8_STAGE(PG8_SA(1, 0), a3, voffA);
            PG8_WAIT_V(8); PG8_WAIT_L(0); PG8_BAR; PG8_MMA(1, 0, At, B0); PG8_MMA(1, 1, At, B1); PG8_BAR; PG8_SCHED;
        }
        if constexpr (ALIGN_EPI) { if (wr == 0) PG8_BAR; }
        E(acc, cur, wr, wc, fr, fq);
        if (!has_next) break;
#pragma unroll
        for (int a = 0; a < 2; ++a)
#pragma unroll
            for (int b = 0; b < 2; ++b)
#pragma unroll
                for (int m = 0; m < 4; ++m)
#pragma unroll
                    for (int n = 0; n < 2; ++n) acc[a][b][m][n] = (f32x4){0.f, 0.f, 0.f, 0.f};
        cur = nxt; cA = nA; cB = nB; ++ui;
        if constexpr (ALIGN_EPI) { if (wr == 1) PG8_BAR; }
    }
    PG8_WAIT_V(0);
    if constexpr (!ALIGN_EPI) { if (wr == 0) PG8_BAR; }
    PG8_BAR;
#undef PG8_SA
#undef PG8_SB
#undef PG8_STAGE
#undef PG8_LDA
#undef PG8_LDB
#undef PG8_MMA
#undef PG8_WAIT_V
#undef PG8_WAIT_L
#undef PG8_BAR
#undef PG8_SCHED
#undef PG8_UA
#undef PG8_UB
}
}

constexpr int NB = 4, TT = 8208, NMETA = 16, SEQ = 8192, D = 1024, NCOL = 7424, PC = 5376, FF = 4096, NH = 16;
constexpr int MT = NB * SEQ;
constexpr int LGSEG = 11, SEGMAX = 1 << LGSEG, MSEGMAX = NB * SEGMAX;
constexpr int NSEG = 1 + SEQ / SEGMAX;
constexpr int OFF_WD = 3072, OFF_XB = 3328, OFF_YB = 4352;
constexpr float RMS_EPS = 1e-6f, LNX_EPS = 64e-5f;

constexpr size_t MiB = 1u << 20;
constexpr size_t WS_BAR = 4 * MiB + 131072;
constexpr size_t WS_SST = 0 * MiB, WS_CHA = 1 * MiB, WS_CHB = 2 * MiB, WS_CAR = 3 * MiB, WS_LST = 4 * MiB, WS_CL = 4 * MiB + 65536;
constexpr size_t WS_WIN = 5 * MiB, WS_WPA = 20 * MiB, WS_WPB = 22 * MiB, WS_WOUT = 24 * MiB, WS_WUP = 26 * MiB, WS_WDN = 34 * MiB, WS_WLORA = 42 * MiB, WS_WLRU = 43 * MiB;
constexpr size_t WS_YA = 44 * MiB, WS_YB = 108 * MiB;
constexpr size_t WS_XN = 172 * MiB, WS_P = 188 * MiB, WS_HALO = 272 * MiB, WS_LA = 273 * MiB, WS_XC = 277 * MiB, WS_L = 293 * MiB, WS_LRA = 341 * MiB, WS_LRB = 373 * MiB;
constexpr size_t WS_R = 389 * MiB  , WS_Y = 390 * MiB, WS_END = 422 * MiB;
static_assert(WS_XN + (size_t)MSEGMAX * D * 2 <= WS_P && WS_P + (size_t)MSEGMAX * PC * 2 <= WS_HALO && WS_LA + (size_t)MSEGMAX * 256 * 2 <= WS_XC && WS_XC + (size_t)MSEGMAX * 1024 * 2 <= WS_L && WS_L + (size_t)MSEGMAX * 3072 * 2 <= WS_LRA && WS_LRA + (size_t)MSEGMAX * 1024 * 4 <= WS_LRB && WS_LRB + (size_t)MSEGMAX * 1024 * 2 <= WS_R && WS_Y + (size_t)MSEGMAX * 1024 * 4 <= WS_END, "segment buffers");
constexpr size_t WS_T1 = 172 * MiB, WS_MIX = 300 * MiB, WS_XN2 = 364 * MiB, WS_Z = 44 * MiB, WS_TAIL_END = 428 * MiB;
constexpr int LDS_BYTES = 135168;

struct Params {
    const float *x, *meta, *norm_mix_g, *w_in, *mu, *w0, *w_decay_up, *a0, *w_aaa_up, *w_gate_up, *k_k, *k_a, *r_k, *ln_w, *ln_b, *w_proj_a, *conv_w, *conv_b,
        *lru_wa, *lru_ba, *lru_wx, *lru_bx, *lru_lambda, *w_proj_b, *w_out, *norm_ffn_g, *w_ff_up, *w_ff_down, *norm_final_g;
    float* out; unsigned char* ws;
};

__device__ __forceinline__ int opaque(int x) { asm volatile("" : "+v"(x)); return x; }
__device__ __forceinline__ unsigned f2bf(float f) { unsigned u = __builtin_bit_cast(unsigned, f); return (u + 0x7fffu + ((u >> 16) & 1u)) >> 16; }
__device__ __forceinline__ unsigned pk2(float lo, float hi) { unsigned r; asm("v_cvt_pk_bf16_f32 %0, %1, %2" : "=v"(r) : "v"(lo), "v"(hi)); return r; }
__device__ __forceinline__ float bflo(unsigned w) { return __builtin_bit_cast(float, w << 16); }
__device__ __forceinline__ float bfhi(unsigned w) { return __builtin_bit_cast(float, w & 0xffff0000u); }
__device__ __forceinline__ float bf1(bf16 h) { return __builtin_bit_cast(float, (unsigned)h << 16); }
__device__ __forceinline__ float rcpf_(float x) { return __builtin_amdgcn_rcpf(x); }
__device__ __forceinline__ float rsqf_(float x) { return __builtin_amdgcn_rsqf(x); }
__device__ __forceinline__ float sqrtf_(float x) { return __builtin_amdgcn_sqrtf(x); }
__device__ __forceinline__ float sigmoidf_(float x) { return rcpf_(1.0f + __expf(-x)); }
__device__ __forceinline__ float tanhf_(float x) { return 1.0f - 2.0f * rcpf_(__expf(2.0f * x) + 1.0f); }
__device__ __forceinline__ float gelu_tanh(float x) { return 0.5f * x * (1.0f + tanhf_(0.7978845608028654f * (x + 0.044715f * x * x * x))); }
__device__ __forceinline__ v4u pack8(f32x4 a, f32x4 b) { v4u w; w.x = pk2(a.x, a.y); w.y = pk2(a.z, a.w); w.z = pk2(b.x, b.y); w.w = pk2(b.z, b.w); return w; }
__device__ __forceinline__ void unpack8(v4u w, float* o) { o[0] = bflo(w.x); o[1] = bfhi(w.x); o[2] = bflo(w.y); o[3] = bfhi(w.y); o[4] = bflo(w.z); o[5] = bfhi(w.z); o[6] = bflo(w.w); o[7] = bfhi(w.w); }
template <int CTRL> __device__ __forceinline__ float dppx(float v) { return __builtin_bit_cast(float, __builtin_amdgcn_update_dpp(0, __builtin_bit_cast(int, v), CTRL, 0xf, 0xf, true)); }
__device__ __forceinline__ float wave_sum(float v) {
    v += dppx<0xB1>(v); v += dppx<0x4E>(v); v += dppx<0x141>(v); v += dppx<0x140>(v);
    v += __shfl_xor(v, 16); v += __shfl_xor(v, 32);
    return v;
}
__device__ __forceinline__ float quad_sum(float v) { v += dppx<0xB1>(v); v += dppx<0x4E>(v); return v; }
__device__ __forceinline__ void load16bf(const bf16* p, float* o) { const v4u a = *(const v4u*)p, b = *(const v4u*)(p + 8); unpack8(a, o); unpack8(b, o + 8); }
__device__ __forceinline__ void load16f(const float* p, float* o) {
#pragma unroll
    for (int j = 0; j < 4; ++j) { const f32x4 v = *(const f32x4*)(p + 4 * j); o[4 * j] = v.x; o[4 * j + 1] = v.y; o[4 * j + 2] = v.z; o[4 * j + 3] = v.w; }
}
__device__ __forceinline__ void store16f(float* p, const float* o) {
#pragma unroll
    for (int j = 0; j < 4; ++j) *(f32x4*)(p + 4 * j) = (f32x4){o[4 * j], o[4 * j + 1], o[4 * j + 2], o[4 * j + 3]};
}
__device__ __forceinline__ void store16bf(bf16* p, const float* o) {
    v4u a, b; a.x = pk2(o[0], o[1]); a.y = pk2(o[2], o[3]); a.z = pk2(o[4], o[5]); a.w = pk2(o[6], o[7]); b.x = pk2(o[8], o[9]); b.y = pk2(o[10], o[11]); b.z = pk2(o[12], o[13]); b.w = pk2(o[14], o[15]);
    *(v4u*)p = a; *(v4u*)(p + 8) = b;
}
__device__ __forceinline__ void shift16(const bf16* cur, const bf16* prev, const float* mu, float* o) {
    float c[16], q[16], m[16]; load16bf(cur, c); load16bf(prev, q); load16f(mu, m);
#pragma unroll
    for (int j = 0; j < 16; ++j) o[j] = c[j] + (q[j] - c[j]) * m[j];
}

__device__ __forceinline__ void transpose_item(const float* W, int K, int N, bf16* WT, LAS float* scr, int item, int lane) {
    const int nblk = N / 32, kb = item / nblk, nb = item % nblk, k0 = 64 * kb, n0 = 32 * nb;
    float wv[32];
#pragma unroll
    for (int i = 0; i < 32; ++i) wv[i] = W[(size_t)(k0 + 2 * i + (lane >> 5)) * N + n0 + (lane & 31)];
#pragma unroll
    for (int i = 0; i < 32; ++i) scr[(2 * i + (lane >> 5)) * 33 + (lane & 31)] = wv[i];
    asm volatile("s_waitcnt lgkmcnt(0)" ::: "memory");
    const int c = lane & 7;
#pragma unroll
    for (int j = 0; j < 4; ++j) { const int n = (lane >> 3) + 8 * j; const LAS float* s = scr + (8 * c) * 33 + n;
        v4u o; o.x = pk2(s[0 * 33], s[1 * 33]); o.y = pk2(s[2 * 33], s[3 * 33]); o.z = pk2(s[4 * 33], s[5 * 33]); o.w = pk2(s[6 * 33], s[7 * 33]);
        *(v4u*)(WT + (size_t)(n0 + n) * K + k0 + 8 * c) = o; }
    asm volatile("s_waitcnt lgkmcnt(0)" ::: "memory");
}
__device__ __forceinline__ void rms_row_to_bf16(const float* xrow, const float* g, bf16* orow, int lane) {
    f32x4 v[4]; float s = 0.f;
#pragma unroll
    for (int j = 0; j < 4; ++j) { v[j] = *((const f32x4*)xrow + lane + 64 * j); s += (v[j].x * v[j].x + v[j].y * v[j].y) + (v[j].z * v[j].z + v[j].w * v[j].w); }
    const float sc = rsqf_(wave_sum(s) * (1.f / D) + RMS_EPS);
#pragma unroll
    for (int j = 0; j < 4; ++j) { const f32x4 gg = *((const f32x4*)g + lane + 64 * j); v2u o; o.x = pk2(v[j].x * sc * gg.x, v[j].y * sc * gg.y); o.y = pk2(v[j].z * sc * gg.z, v[j].w * sc * gg.w);
        *((v2u*)orow + lane + 64 * j) = o; }
}

__device__ __forceinline__ void rms_rows4_to_bf16(const float* x0, const float* x1, const float* x2, const float* x3, const float* g, bf16* o0, bf16* o1, bf16* o2, bf16* o3, int lane) {
    const float* xs[4] = {x0, x1, x2, x3}; bf16* os[4] = {o0, o1, o2, o3};
    f32x4 v[4][4];
#pragma unroll
    for (int r = 0; r < 4; ++r)
#pragma unroll
        for (int j = 0; j < 4; ++j) v[r][j] = *((const f32x4*)xs[r] + lane + 64 * j);
    f32x4 gg[4];
#pragma unroll
    for (int j = 0; j < 4; ++j) gg[j] = *((const f32x4*)g + lane + 64 * j);
#pragma unroll
    for (int r = 0; r < 4; ++r) {
        float s = 0.f;
#pragma unroll
        for (int j = 0; j < 4; ++j) s += (v[r][j].x * v[r][j].x + v[r][j].y * v[r][j].y) + (v[r][j].z * v[r][j].z + v[r][j].w * v[r][j].w);
        const float sc = rsqf_(wave_sum(s) * (1.f / D) + RMS_EPS);
#pragma unroll
        for (int j = 0; j < 4; ++j) { v2u o; o.x = pk2(v[r][j].x * sc * gg[j].x, v[r][j].y * sc * gg[j].y); o.y = pk2(v[r][j].z * sc * gg[j].z, v[r][j].w * sc * gg[j].w); *((v2u*)os[r] + lane + 64 * j) = o; }
    }
}

__device__ __forceinline__ void st_nt(void* p, v4u v) { __builtin_nontemporal_store(v, (v4u*)p); }

struct OpP {
    bf16* P; bf16* halo_next; bf16* gates; int Mseg, lgT, gbase, s;
    __device__ __forceinline__ void operator()(int row, int col, f32x4 v0, f32x4 v1) const {
        if (row >= Mseg) return;
        const v4u w = pack8(v0, v1); const int b = row >> lgT, SEGT = 1 << lgT, i = row & (SEGT - 1);
        if (col < PC) {
            st_nt(P + (size_t)row * PC + col, w);
            if (i >= SEGT - 3) *(v4u*)(halo_next + (size_t)(b * 3 + (i - (SEGT - 3))) * PC + col) = w;
        } else if (s > 0) {
            st_nt(gates + ((size_t)b * SEQ + gbase + i) * 2048 + (col - PC), w);
        }
    }
};
struct OpLora {
    bf16* L; int Mseg;
    __device__ __forceinline__ void operator()(int row, int col, f32x4 v0, f32x4 v1) const {
        if (row >= Mseg) return;
        st_nt(L + (size_t)row * 3072 + col, pack8(v0, v1));
    }
};
struct OpLru {
    float* LRA; bf16* LRB; const bf16* XC; const float* CL; const float* ba; const float* bx; int Mseg;
    __device__ __forceinline__ void operator()(int row, int col, f32x4 v0, f32x4 v1) const {
        if (row >= Mseg) return;
        float v[8] = {v0.x, v0.y, v0.z, v0.w, v1.x, v1.y, v1.z, v1.w};
        const int pj = col >> 8, nn = col & 255, blk = nn >> 7, gate = (nn >> 6) & 1, j = nn & 63, ch = 64 * (2 * pj + blk) + j;
        if (gate == 0) {
            float cl[8], bb[8]; { const f32x4 c0 = *(const f32x4*)(CL + ch), c1 = *(const f32x4*)(CL + ch + 4), b0 = *(const f32x4*)(ba + ch), b1 = *(const f32x4*)(ba + ch + 4);
                cl[0] = c0.x; cl[1] = c0.y; cl[2] = c0.z; cl[3] = c0.w; cl[4] = c1.x; cl[5] = c1.y; cl[6] = c1.z; cl[7] = c1.w; bb[0] = b0.x; bb[1] = b0.y; bb[2] = b0.z; bb[3] = b0.w; bb[4] = b1.x; bb[5] = b1.y; bb[6] = b1.z; bb[7] = b1.w; }
#pragma unroll
            for (int e = 0; e < 8; ++e) v[e] = __expf(cl[e] * sigmoidf_(v[e] + bb[e]));
            float* o = LRA + (size_t)row * 1024 + ch;
            *(f32x4*)o = (f32x4){v[0], v[1], v[2], v[3]}; *(f32x4*)(o + 4) = (f32x4){v[4], v[5], v[6], v[7]};
        } else {
            float xc[8]; unpack8(*(const v4u*)(XC + (size_t)row * 1024 + ch), xc);
            float bb[8]; { const f32x4 b0 = *(const f32x4*)(bx + ch), b1 = *(const f32x4*)(bx + ch + 4); bb[0] = b0.x; bb[1] = b0.y; bb[2] = b0.z; bb[3] = b0.w; bb[4] = b1.x; bb[5] = b1.y; bb[6] = b1.z; bb[7] = b1.w; }
#pragma unroll
            for (int e = 0; e < 8; ++e) v[e] = sigmoidf_(v[e] + bb[e]) * xc[e];
            st_nt(LRB + (size_t)row * 1024 + ch, pack8((f32x4){v[0], v[1], v[2], v[3]}, (f32x4){v[4], v[5], v[6], v[7]}));
        }
    }
};
struct OpT1 {
    bf16* T1; const bf16* gates;
    __device__ __forceinline__ void operator()(int row, int col, f32x4 v0, f32x4 v1) const {
        float gt[8]; unpack8(*(const v4u*)(gates + (size_t)row * 2048 + col), gt);
        const f32x4 a = {sigmoidf_(gt[0]) * v0.x, sigmoidf_(gt[1]) * v0.y, sigmoidf_(gt[2]) * v0.z, sigmoidf_(gt[3]) * v0.w};
        const f32x4 b = {sigmoidf_(gt[4]) * v1.x, sigmoidf_(gt[5]) * v1.y, sigmoidf_(gt[6]) * v1.z, sigmoidf_(gt[7]) * v1.w};
        *(v4u*)(T1 + (size_t)row * 1024 + col) = pack8(a, b);
    }
};
struct OpMix {
    const bf16* T1; const bf16* gates; bf16* MIX;
    __device__ __forceinline__ void operator()(int row, int col, f32x4 v0, f32x4 v1) const {
        float gt[8], t[8]; unpack8(*(const v4u*)(gates + (size_t)row * 2048 + 1024 + col), gt); unpack8(*(const v4u*)(T1 + (size_t)row * 1024 + col), t);
        const f32x4 a = {t[0] + sigmoidf_(gt[0]) * v0.x, t[1] + sigmoidf_(gt[1]) * v0.y, t[2] + sigmoidf_(gt[2]) * v0.z, t[3] + sigmoidf_(gt[3]) * v0.w};
        const f32x4 b = {t[4] + sigmoidf_(gt[4]) * v1.x, t[5] + sigmoidf_(gt[5]) * v1.y, t[6] + sigmoidf_(gt[6]) * v1.z, t[7] + sigmoidf_(gt[7]) * v1.w};
        *(v4u*)(MIX + (size_t)row * 1024 + col) = pack8(a, b);
    }
};
struct OpH1 {
    const float* x; float* out; const float* gff; bf16* XN2; float* SS;
    __device__ __forceinline__ void operator()(int row, int col, f32x4 v0, f32x4 v1) const {
        const size_t o = (size_t)row * 1024 + col; const f32x4 a = *(const f32x4*)(x + o) + v0, b = *(const f32x4*)(x + o + 4) + v1;
        *(f32x4*)(out + o) = a; *(f32x4*)(out + o + 4) = b;
        const f32x4 g0 = *(const f32x4*)(gff + col), g1 = *(const f32x4*)(gff + col + 4);
        *(v4u*)(XN2 + o) = pack8(a * g0, b * g1);
        float ss = (a.x * a.x + a.y * a.y) + (a.z * a.z + a.w * a.w) + (b.x * b.x + b.y * b.y) + (b.z * b.z + b.w * b.w);
        ss += __shfl_xor(ss, 16); ss += __shfl_xor(ss, 32);
        if ((threadIdx.x & 63) < 16) atomicAdd(SS + row, ss);
    }
};
struct OpZ {
    bf16* Z; const float* SS;
    __device__ __forceinline__ void operator()(int row, int col, f32x4 v0, f32x4 v1) const {
        const float rs = rsqf_(SS[row] * (1.f / D) + RMS_EPS);
        f32x4 a, b;
        a.x = fmaxf(v0.x, 0.f); a.y = fmaxf(v0.y, 0.f); a.z = fmaxf(v0.z, 0.f); a.w = fmaxf(v0.w, 0.f); b.x = fmaxf(v1.x, 0.f); b.y = fmaxf(v1.y, 0.f); b.z = fmaxf(v1.z, 0.f); b.w = fmaxf(v1.w, 0.f);
        a = a * rs; b = b * rs;
        st_nt(Z + (size_t)row * FF + col, pack8(a * a, b * b));
    }
};
struct OpAcc {
    float* out;
    __device__ __forceinline__ void operator()(int row, int col, f32x4 v0, f32x4 v1) const {
        float* o = out + (size_t)row * 1024 + col; const f32x4 a = *(const f32x4*)o, b = *(const f32x4*)(o + 4);
        *(f32x4*)o = a + v0; *(f32x4*)(o + 4) = b + v1;
    }
};
template <class Op, bool ALIGN>
__device__ __forceinline__ void run_gemm(LAS unsigned char* lds, const bf16* A, int lda, const bf16* Bt, int M, int N, int K, int ash, int amul, const Op& op) {
    pg8::Gemm g{A, Bt, M, N, K, lda, ash, amul}; pg8::StaticOrder S; S.init(M, N, (int)gridDim.x, (int)blockIdx.x);
    pg8::EpiOp<Op> E{op};
    pg8::gemm_phase<pg8::EpiOp<Op>, pg8::StaticOrder, ALIGN>(lds, g, S, E);
}

constexpr int CH = 32, REC = 336  , CHBYTES = CH * REC * 4;
__device__ __forceinline__ float dppf(float v, const int ctrl_sel) {
    const int x = __builtin_bit_cast(int, v); int r;
    if (ctrl_sel == 0) r = __builtin_amdgcn_update_dpp(0, x, 0xB1, 0xf, 0xf, true);
    else if (ctrl_sel == 1) r = __builtin_amdgcn_update_dpp(0, x, 0x4E, 0xf, 0xf, true);
    else if (ctrl_sel == 2) r = __builtin_amdgcn_update_dpp(0, x, 0x141, 0xf, 0xf, true);
    else r = __builtin_amdgcn_update_dpp(0, x, 0x140, 0xf, 0xf, true);
    return __builtin_bit_cast(float, r);
}
__device__ __forceinline__ float red16(float v) { v += dppf(v, 0); v += dppf(v, 1); v += dppf(v, 2); v += dppf(v, 3); return v; }

__device__ __forceinline__ float red32(float v) {
    v = red16(v); float a = v, b = v;
    asm volatile("s_nop 1\n\tv_permlane16_swap_b32 %0, %1" : "+v"(a), "+v"(b));
    return a + b;
}
struct ScanRegs { f32x4 a[5]; f32x4 v; };
__device__ __forceinline__ void scan_load(ScanRegs& R, const float* const* arr, const float* V, int mrow, int hcol, int vcol, int pt) {
    const int j = pt >> 4, q = pt & 15;
#pragma unroll
    for (int a = 0; a < 5; ++a) R.a[a] = *(const f32x4*)(arr[a] + (size_t)(mrow + j) * 1024 + hcol + 4 * q);
    R.v = *(const f32x4*)(V + (size_t)(mrow + ((pt & 63) >> 2)) * 1024 + vcol + 4 * (pt & 3));
}
__device__ __forceinline__ void scan_write(const ScanRegs& R, LAS unsigned char* buf, int pt) {
    const int j = pt >> 4, q = pt & 15;
#pragma unroll
    for (int a = 0; a < 5; ++a) *(LAS f32x4*)(buf + j * (REC * 4) + a * 256 + q * 16) = R.a[a];
    if (pt < 64) *(LAS f32x4*)(buf + (pt >> 2) * (REC * 4) + 1280 + (pt & 3) * 16) = R.v;
}

#define DECL_PTRS \
    GAS unsigned char* wsg_ = (GAS unsigned char*)p.ws; asm volatile("" : "+s"(wsg_)); unsigned char* ws = (unsigned char*)wsg_;     \
    float* SST = (float*)(ws + WS_SST); float* CHA = (float*)(ws + WS_CHA); float* CHBv = (float*)(ws + WS_CHB); float* CAR = (float*)(ws + WS_CAR); float* LST = (float*)(ws + WS_LST); float* CL = (float*)(ws + WS_CL); \
    bf16* Win_t = (bf16*)(ws + WS_WIN); bf16* Wpa_t = (bf16*)(ws + WS_WPA); bf16* Wpb_t = (bf16*)(ws + WS_WPB); bf16* Wout_t = (bf16*)(ws + WS_WOUT); bf16* Wup_t = (bf16*)(ws + WS_WUP); bf16* Wdn_t = (bf16*)(ws + WS_WDN); \
    bf16* Wlora_t = (bf16*)(ws + WS_WLORA); bf16* Wlru_t = (bf16*)(ws + WS_WLRU); \
    bf16* YA = (bf16*)(ws + WS_YA); bf16* YB = (bf16*)(ws + WS_YB); \
    bf16* XN = (bf16*)(ws + WS_XN); bf16* P = (bf16*)(ws + WS_P); bf16* HALO = (bf16*)(ws + WS_HALO); bf16* LA = (bf16*)(ws + WS_LA); bf16* XC = (bf16*)(ws + WS_XC); \
    bf16* L = (bf16*)(ws + WS_L); float* LRA = (float*)(ws + WS_LRA); bf16* LRB = (bf16*)(ws + WS_LRB); \
    float* SB = (float*)(ws + WS_R); float* Yr = (float*)(ws + WS_Y); \
    bf16* T1 = (bf16*)(ws + WS_T1); bf16* MIX = (bf16*)(ws + WS_MIX); bf16* XN2 = (bf16*)(ws + WS_XN2); bf16* Z = (bf16*)(ws + WS_Z); \
    bf16* GATES = (bf16*)p.out;

#define XB_TMO      128
#define XB_XCNT(j)  (256  + 64 * (j))
#define XB_XSUB(j)  (1280 + 64 * (j))
#define XB_XGEN(j)  (2304 + 64 * (j))
#define XB_TOP      3328
#define XB_TOPGEN   3392
#define XCD_BAR_WORDS 3456
#define XB_SPIN_CAP (1u << 18)

__device__ __forceinline__ unsigned xb_ld(unsigned* p)              { return __hip_atomic_load(p, __ATOMIC_RELAXED, __HIP_MEMORY_SCOPE_AGENT); }
__device__ __forceinline__ unsigned xb_add(unsigned* p, unsigned v) { return __hip_atomic_fetch_add(p, v, __ATOMIC_RELAXED, __HIP_MEMORY_SCOPE_AGENT); }
__device__ __forceinline__ unsigned xb_xcc_id() { return (unsigned)__builtin_amdgcn_s_getreg((3 << 11) | 20) & 0xFu; }
#define XB_SPIN(cond, bar) do { unsigned _sp = 0; while (cond) { __builtin_amdgcn_s_sleep(1); \
    if ((++_sp & 255u) == 0u) { if (xb_ld(&(bar)[XB_TMO])) break; if (_sp > XB_SPIN_CAP) { atomicAdd(&(bar)[XB_TMO], 1u); break; } } } } while (0)

struct XcdBarrier {
    unsigned* bar; unsigned x;
    volatile LAS unsigned* st;
};

__device__ __forceinline__ XcdBarrier xcd_barrier_post(unsigned* bar, volatile LAS unsigned* st) {
    XcdBarrier b; b.bar = bar; b.x = xb_xcc_id(); b.st = st;
    if (threadIdx.x == 0) (void)xb_add(&bar[XB_XCNT(b.x)], 1u);
    return b;
}
__device__ __forceinline__ void xcd_barrier_complete(unsigned* bar, unsigned x, unsigned& nloc, unsigned& nx) {
    const unsigned G = gridDim.x * gridDim.y * gridDim.z;
    unsigned sum, cnt, mine, sp = 0u;
    for (;;) {
        sum = 0u; cnt = 0u; mine = 0u;
#pragma unroll
        for (unsigned j = 0; j < 16; ++j) { const unsigned c = xb_ld(&bar[XB_XCNT(j)]); sum += c; cnt += (c > 0u) ? 1u : 0u; mine = (j == x) ? c : mine; }
        if (sum == G) break;
        __builtin_amdgcn_s_sleep(1);
        if ((++sp & 255u) == 0u) { if (xb_ld(&bar[XB_TMO])) break; if (sp > XB_SPIN_CAP) { atomicAdd(&bar[XB_TMO], 1u); break; } }
    }
    nloc = mine > 0u ? mine : 1u; nx = cnt > 0u ? cnt : 1u;
}

__device__ __forceinline__ void xcd_barrier(const XcdBarrier& b) {
    asm volatile("s_waitcnt vmcnt(0)" ::: "memory");
    __syncthreads();
    if (threadIdx.x == 0) {
        unsigned* bar = b.bar;
        __builtin_amdgcn_s_waitcnt(0);
        unsigned nloc = b.st[0], nx = b.st[1];
        if (nloc == 0u) { xcd_barrier_complete(bar, b.x, nloc, nx); b.st[0] = nloc; b.st[1] = nx; }
        const unsigned old = xb_add(&bar[XB_XSUB(b.x)], 1u);
        const unsigned gen = old / nloc;
        if (old + 1u == (gen + 1u) * nloc) {
            __builtin_amdgcn_fence(__ATOMIC_RELEASE, "agent");
            asm volatile("s_waitcnt vmcnt(0)" ::: "memory");
            const unsigned og = xb_add(&bar[XB_TOP], 1u);
            const unsigned tg = og / nx;
            if (og + 1u == (tg + 1u) * nx) xb_add(&bar[XB_TOPGEN], 1u);
            else XB_SPIN(xb_ld(&bar[XB_TOPGEN]) == tg, bar);
            __builtin_amdgcn_fence(__ATOMIC_ACQUIRE, "agent");
            xb_add(&bar[XB_XGEN(b.x)], 1u);
            asm volatile("s_waitcnt vmcnt(0)" ::: "memory");
        } else {
            XB_SPIN(xb_ld(&bar[XB_XGEN(b.x)]) == gen, bar);
            __builtin_amdgcn_fence(__ATOMIC_ACQUIRE, "agent");
            asm volatile("s_waitcnt vmcnt(0)" ::: "memory");
        }
    }
    __syncthreads();
}

#define LBAR() asm volatile("s_waitcnt lgkmcnt(0)\n\ts_barrier" ::: "memory")
#ifndef PROBE
#define PROBE 0
#endif
#define REP(k) for (int rep_ = 0; rep_ < ((PROBE == (k)) ? 2 : 1); ++rep_)
__global__ void __launch_bounds__(512, 2) fwd_megakernel(Params p) {
    extern __shared__ __attribute__((aligned(16))) unsigned char lds_raw[];
    cg::grid_group grid = cg::this_grid();
    LAS unsigned char* lds = (LAS unsigned char*)lds_raw;
    const int tid = threadIdx.x, lane = tid & 63, wave = __builtin_amdgcn_readfirstlane(tid >> 6);
    const int G = gridDim.x, bid = blockIdx.x, gw = bid * 8 + wave, NGW = G * 8, NGT = G * 512;
#define gtid (bid * 512 + opaque(tid))
    constexpr int HALO_PAR = NB * 3 * PC;

    REP(14) {
        DECL_PTRS
        LAS float* scr = (LAS float*)(lds + wave * 16384);
        const int lane = opaque(tid) & 63;
        constexpr int I_IN = (D / 64) * (NCOL / 32), I_SQ = (D / 64) * (D / 32), I_UP = (D / 64) * (FF / 32), I_DN = (FF / 64) * (D / 32);
        constexpr int NITEMS = I_IN + 3 * I_SQ + I_UP + I_DN;
        for (int it = gw; it < NITEMS; it += NGW) {
            int r = it;
            if (r < I_IN) { transpose_item(p.w_in, D, NCOL, Win_t, scr, r, lane); continue; } r -= I_IN;
            if (r < I_SQ) { transpose_item(p.w_proj_a, D, D, Wpa_t, scr, r, lane); continue; } r -= I_SQ;
            if (r < I_SQ) { transpose_item(p.w_proj_b, D, D, Wpb_t, scr, r, lane); continue; } r -= I_SQ;
            if (r < I_SQ) { transpose_item(p.w_out, D, D, Wout_t, scr, r, lane); continue; } r -= I_SQ;
            if (r < I_UP) { transpose_item(p.w_ff_up, D, FF, Wup_t, scr, r, lane); continue; } r -= I_UP;
            transpose_item(p.w_ff_down, FF, D, Wdn_t, scr, r, lane);
        }
        for (int e = gtid; e < 3072 * 128; e += NGT) {
            const int n = e >> 7, k = e & 127; float v;
            if (n < 1024) v = (k < 64) ? p.w_decay_up[k * 1024 + n] : 0.f;
            else if (n < 2048) v = (k >= 64) ? p.w_aaa_up[(k - 64) * 1024 + (n - 1024)] : 0.f;
            else v = p.w_gate_up[k * 1024 + (n - 2048)];
            Wlora_t[e] = (bf16)f2bf(v);
        }
        for (int e = gtid; e < 2048 * 128; e += NGT) {
            const int n = e >> 7, k = e & 127, pj = n >> 8, nn = n & 255, blk = nn >> 7, gate = (nn >> 6) & 1, j = nn & 63, kb = k >> 6, i = k & 63;
            const float* W = gate ? p.lru_wx : p.lru_wa;
            const float v = (kb == blk) ? W[((2 * pj + blk) * 64 + i) * 64 + j] : 0.f;
            Wlru_t[e] = (bf16)f2bf(v);
        }
        for (int e = gtid; e < HALO_PAR / 2; e += NGT) ((unsigned*)HALO)[e] = 0u;
        for (int e = gtid; e < 256 * 4 * 64 * 4; e += NGT) SST[e] = 0.f;
        for (int e = gtid; e < NB * 1024; e += NGT) LST[e] = 0.f;
        for (int e = gtid; e < 1024; e += NGT) CL[e] = -8.0f * log1pf(__expf(-p.lru_lambda[e]));
        for (int m = gw; m < NB * NMETA; m += NGW) rms_row_to_bf16(p.meta + (size_t)(m & 15) * D, p.norm_mix_g, XN + (size_t)m * D, opaque(tid) & 63);
        for (int e = gtid; e < XCD_BAR_WORDS; e += NGT) __hip_atomic_store((unsigned*)(ws + WS_BAR) + e, 0u, __ATOMIC_RELAXED, __HIP_MEMORY_SCOPE_AGENT);
        if (tid < 16) ((volatile LAS unsigned*)(lds + 131072))[tid] = 0u;
    }
    grid.sync();
    const XcdBarrier xbar = xcd_barrier_post((unsigned*)(p.ws + WS_BAR), (volatile LAS unsigned*)(lds + 131072) + 8);
#define GRID_SYNC() xcd_barrier(xbar)

    for (int s = 0; s < NSEG; ++s) {
        const int lgT = (s == 0) ? 4 : LGSEG, SEGT = 1 << lgT, Mseg = NB * SEGT, Mpad = (s == 0) ? 256 : MSEGMAX, gbase = (s == 0) ? 0 : (s - 1) * SEGMAX, nch = SEGT / CH;
        REP(5) { DECL_PTRS bf16* halo_next = HALO + (size_t)((s + 1) & 1) * HALO_PAR; OpP op{P, halo_next, GATES, Mseg, lgT, gbase, s}; run_gemm<OpP, true>(lds, XN, D, Win_t, Mpad, NCOL, D, 0, 0, op); }
        GRID_SYNC();
        REP(6) { DECL_PTRS const bf16* halo_cur = HALO + (size_t)(s & 1) * HALO_PAR;
        for (int m = gw; m < Mseg; m += NGW) {
            const int lane = opaque(tid) & 63;
            const int b = m >> lgT, i = m & (SEGT - 1);
            const bf16* cur = P + (size_t)m * PC;
            const bf16* pr1 = (i >= 1) ? cur - PC : halo_cur + (size_t)(b * 3 + 2) * PC;
            const bf16* pr2 = (i >= 2) ? cur - 2 * PC : halo_cur + (size_t)(b * 3 + 1 + i) * PC;
            const bf16* pr3 = (i >= 3) ? cur - 3 * PC : halo_cur + (size_t)(b * 3 + i) * PC;
            {
                const int c = 4 * lane; const v2u cw = *(const v2u*)(cur + OFF_WD + c), pw = *(const v2u*)(pr1 + OFF_WD + c); const f32x4 mu = *(const f32x4*)(p.mu + OFF_WD + c);
                float x0 = bflo(cw.x), x1 = bfhi(cw.x), x2 = bflo(cw.y), x3 = bfhi(cw.y);
                x0 += (bflo(pw.x) - x0) * mu.x; x1 += (bfhi(pw.x) - x1) * mu.y; x2 += (bflo(pw.y) - x2) * mu.z; x3 += (bfhi(pw.y) - x3) * mu.w;
                if (lane < 16) { x0 = tanhf_(x0); x1 = tanhf_(x1); x2 = tanhf_(x2); x3 = tanhf_(x3); }
                else if (lane >= 32) { x0 = sigmoidf_(x0); x1 = sigmoidf_(x1); x2 = sigmoidf_(x2); x3 = sigmoidf_(x3); }
                v2u o; o.x = pk2(x0, x1); o.y = pk2(x2, x3); *(v2u*)(LA + (size_t)m * 256 + c) = o;
            }
            {
                const int c = 16 * lane; float x0[16], x1[16], x2[16], x3[16], w[16], o[16];
                load16bf(pr3 + OFF_XB + c, x0); load16bf(pr2 + OFF_XB + c, x1); load16bf(pr1 + OFF_XB + c, x2); load16bf(cur + OFF_XB + c, x3);
                load16f(p.conv_b + c, o);
                load16f(p.conv_w + c, w);
#pragma unroll
                for (int j = 0; j < 16; ++j) o[j] += x0[j] * w[j];
                load16f(p.conv_w + 1024 + c, w);
#pragma unroll
                for (int j = 0; j < 16; ++j) o[j] += x1[j] * w[j];
                load16f(p.conv_w + 2048 + c, w);
#pragma unroll
                for (int j = 0; j < 16; ++j) o[j] += x2[j] * w[j];
                load16f(p.conv_w + 3072 + c, w);
#pragma unroll
                for (int j = 0; j < 16; ++j) o[j] += x3[j] * w[j];
                store16bf(XC + (size_t)m * 1024 + c, o);
            }
        } }
        GRID_SYNC();
        REP(7) { DECL_PTRS OpLora op{L, Mseg}; run_gemm<OpLora, true>(lds, LA, 256, Wlora_t, Mpad, 3072, 128, 3, 128, op); }
        REP(7) { DECL_PTRS OpLru op{LRA, LRB, XC, CL, p.lru_ba, p.lru_bx, Mseg}; run_gemm<OpLru, true>(lds, XC, 1024, Wlru_t, Mpad, 2048, 128, 0, 128, op); }
        GRID_SYNC();
        REP(3) { DECL_PTRS const bf16* halo_cur = HALO + (size_t)(s & 1) * HALO_PAR;
        const int lch = (SEGT < 32) ? SEGT : 32, nlc = SEGT / lch;
        const bool lru_bg = (s >= 1) && (G == 256) && (SEGT == 2048);
        if (!lru_bg)
        for (int idx = gtid; idx < NB * nlc * 512; idx += NGT) {
            const int c = 2 * (idx & 511), q = idx >> 9, chunk = q % nlc, b = q / nlc; const size_t m0 = (size_t)b * SEGT + chunk * lch;
            f32x2 ap = {1.f, 1.f}, bacc = {0.f, 0.f};
#pragma unroll 32
            for (int j = 0; j < lch; ++j) { const f32x2 a = *(const f32x2*)(LRA + (m0 + j) * 1024 + c); const unsigned lb = *(const unsigned*)(LRB + (m0 + j) * 1024 + c);
                const f32x2 bb = {sqrtf_(fmaxf(1.0f - a.x * a.x, 0.f)) * bflo(lb), sqrtf_(fmaxf(1.0f - a.y * a.y, 0.f)) * bfhi(lb)}; bacc = a * bacc + bb; ap = ap * a; }
            *(f32x2*)(CHA + (size_t)(b * 64 + chunk) * 1024 + c) = ap; *(f32x2*)(CHBv + (size_t)(b * 64 + chunk) * 1024 + c) = bacc;
        }
        const int nch = (SEGT + CH - 1) / CH;
        for (int u = bid; u < 256; u += G) {
            const int tq = opaque(tid), lane = tq & 63;
            const int bh = (u & 7) * 8 + ((u >> 3) >> 2), rg = (u >> 3) & 3, b = bh >> 4, h = bh & 15, mrow0 = b * SEGT, hcol = h * 64, vcol = hcol + rg * 16;
            __syncthreads();
            if (wave >= 4) {
                const int pt = tq - 256, pj = pt >> 4, pq = pt & 15, pc = hcol + 4 * pq;
                const f32x4 mu_r = *(const f32x4*)(p.mu + pc), mu_k = *(const f32x4*)(p.mu + 1024 + pc), mu_v = *(const f32x4*)(p.mu + 2048 + pc), c_w0 = *(const f32x4*)(p.w0 + pc), c_a0 = *(const f32x4*)(p.a0 + pc),
                            c_kk = *(const f32x4*)(p.k_k + pc), c_ka = *(const f32x4*)(p.k_a + pc), c_rk = *(const f32x4*)(p.r_k + pc);
                const bf16* halo_b = halo_cur + (size_t)(b * 3 + 2) * PC;
#define PREP_DECL(X) v2u X##rc, X##rp, X##kc, X##kp, X##vc, X##vp, X##ld, X##la
                PREP_DECL(A0); PREP_DECL(A1); PREP_DECL(B0); PREP_DECL(B1);
#define PREP_LOAD(X, cc, toff) { const int tj_ = (cc) * CH + pj + (toff); const bf16* cur_ = P + (size_t)(mrow0 + tj_) * PC; const bf16* prv_ = (tj_ >= 1) ? cur_ - PC : halo_b; \
                X##rc = *(const v2u*)(cur_ + pc); X##rp = *(const v2u*)(prv_ + pc); X##kc = *(const v2u*)(cur_ + 1024 + pc); X##kp = *(const v2u*)(prv_ + 1024 + pc); X##vc = *(const v2u*)(cur_ + 2048 + pc); X##vp = *(const v2u*)(prv_ + 2048 + pc); \
                const bf16* l_ = L + (size_t)(mrow0 + tj_) * 3072 + pc; X##ld = *(const v2u*)l_; X##la = *(const v2u*)(l_ + 1024); }
#define SHIFT4(C, Q, MU) ((f32x4){bflo(C.x) + (bflo(Q.x) - bflo(C.x)) * MU.x, bfhi(C.x) + (bfhi(Q.x) - bfhi(C.x)) * MU.y, bflo(C.y) + (bflo(Q.y) - bflo(C.y)) * MU.z, bfhi(C.y) + (bfhi(Q.y) - bfhi(C.y)) * MU.w})
#define PREP_CW(X, cc, bufp, toff) { const int tj_ = (cc) * CH + pj + (toff); LAS unsigned char* rec_ = (bufp) + (pj + (toff)) * (REC * 4); const bool ok_ = tj_ < SEGT; \
                const f32x4 r_ = SHIFT4(X##rc, X##rp, mu_r), k_ = SHIFT4(X##kc, X##kp, mu_k), v_ = SHIFT4(X##vc, X##vp, mu_v); \
                f32x4 w_, a_; w_.x = __expf(-0.6065306597126334f * sigmoidf_(c_w0.x + bflo(X##ld.x))); w_.y = __expf(-0.6065306597126334f * sigmoidf_(c_w0.y + bfhi(X##ld.x))); w_.z = __expf(-0.6065306597126334f * sigmoidf_(c_w0.z + bflo(X##ld.y))); w_.w = __expf(-0.6065306597126334f * sigmoidf_(c_w0.w + bfhi(X##ld.y))); \
                a_.x = sigmoidf_(c_a0.x + bflo(X##la.x)); a_.y = sigmoidf_(c_a0.y + bfhi(X##la.x)); a_.z = sigmoidf_(c_a0.z + bflo(X##la.y)); a_.w = sigmoidf_(c_a0.w + bfhi(X##la.y)); \
                f32x4 q_ = k_ * c_kk; const float ss_ = red16((q_.x * q_.x + q_.y * q_.y) + (q_.z * q_.z + q_.w * q_.w)); q_ = q_ * rsqf_(fmaxf(ss_, 1e-24f)); \
                f32x4 km_ = k_ * (1.0f + (a_ - 1.0f) * c_ka), bb_ = q_ * a_; \
                const f32x4 rk_ = r_ * km_ * c_rk; const float sb_ = red16((rk_.x + rk_.y) + (rk_.z + rk_.w)); \
                if (rg == 0 && pq == 0 && ok_) SB[(size_t)(mrow0 + tj_) * 16 + h] = sb_; \
                if (!ok_) { w_ = (f32x4){1.f, 1.f, 1.f, 1.f}; km_ = (f32x4){0.f, 0.f, 0.f, 0.f}; bb_ = km_; q_ = km_; }     \
                *(LAS f32x4*)(rec_ + pq * 16) = ok_ ? r_ : (f32x4){0.f, 0.f, 0.f, 0.f}; *(LAS f32x4*)(rec_ + 256 + pq * 16) = w_; *(LAS f32x4*)(rec_ + 512 + pq * 16) = km_; *(LAS f32x4*)(rec_ + 768 + pq * 16) = q_; *(LAS f32x4*)(rec_ + 1024 + pq * 16) = bb_; \
                if ((pq >> 2) == rg) *(LAS f32x4*)(rec_ + 1280 + (pq & 3) * 16) = ok_ ? v_ : (f32x4){0.f, 0.f, 0.f, 0.f}; }
#define CLAMPC(x) (((x) < nch) ? (x) : nch - 1)
                PREP_LOAD(A0, 0, 0); PREP_LOAD(A1, 0, 16); PREP_LOAD(B0, CLAMPC(1), 0); PREP_LOAD(B1, CLAMPC(1), 16);
                PREP_CW(A0, 0, lds, 0); PREP_CW(A1, 0, lds, 16); PREP_LOAD(A0, CLAMPC(2), 0); PREP_LOAD(A1, CLAMPC(2), 16);
                const float one_ = __builtin_bit_cast(float, opaque(0x3f800000)), zero_ = __builtin_bit_cast(float, opaque(0));
                f32x2 l_ap = {one_, one_}, l_b = {zero_, zero_};
                for (int c = 0; c < nch; c += 2) {
                    LBAR();
                    if (c + 1 < nch) { PREP_CW(B0, c + 1, lds + CHBYTES, 0); PREP_CW(B1, c + 1, lds + CHBYTES, 16); PREP_LOAD(B0, CLAMPC(c + 3), 0); PREP_LOAD(B1, CLAMPC(c + 3), 16); }
                    const bool dolru = lru_bg && (u == bid) && ((c & 7) == 4);
                    const int lsel = c >> 3, lidx = bid * 512 + pt + 256 * (lsel >> 2), lhb = lsel & 3;
                    const int lc = 2 * (lidx & 511), lq = lidx >> 9, lchunk = lq & 63, lb2 = lq >> 6; const size_t lm0 = (size_t)lb2 * SEGT + lchunk * 32 + lhb * 8;
                    f32x2 la[8]; unsigned lbv[8];
                    if (dolru) {
#pragma unroll
                        for (int j = 0; j < 8; ++j) { la[j] = *(const f32x2*)(LRA + (lm0 + j) * 1024 + lc); lbv[j] = *(const unsigned*)(LRB + (lm0 + j) * 1024 + lc); }
                    } else {
#pragma unroll
                        for (int j = 0; j < 8; ++j) { la[j] = (f32x2){zero_, zero_}; lbv[j] = 0u; }
                    }
                    if (c + 1 >= nch) break;
                    LBAR();
                    if (c + 2 < nch) { PREP_CW(A0, c + 2, lds, 0); PREP_CW(A1, c + 2, lds, 16); PREP_LOAD(A0, CLAMPC(c + 4), 0); PREP_LOAD(A1, CLAMPC(c + 4), 16); }
                    if (dolru) {
                        if (lhb == 0) { l_ap = (f32x2){one_, one_}; l_b = (f32x2){zero_, zero_}; }
#pragma unroll
                        for (int j = 0; j < 8; ++j) { const f32x2 a = la[j]; const f32x2 bb = {sqrtf_(fmaxf(1.0f - a.x * a.x, 0.f)) * bflo(lbv[j]), sqrtf_(fmaxf(1.0f - a.y * a.y, 0.f)) * bfhi(lbv[j])}; l_b = a * l_b + bb; l_ap = l_ap * a; }
                        if (lhb == 3) { *(f32x2*)(CHA + (size_t)(lb2 * 64 + lchunk) * 1024 + lc) = l_ap; *(f32x2*)(CHBv + (size_t)(lb2 * 64 + lchunk) * 1024 + lc) = l_b; }
                    }
                }
#undef PREP_DECL
#undef PREP_LOAD
#undef PREP_CW
#undef SHIFT4
#undef CLAMPC
            } else {
                const int g4 = lane >> 4, kq = lane & 15;
                float* sst = SST + ((size_t)(u * 4 + wave) * 64 + lane) * 4;
                f32x2 S01, S23; { const f32x4 S = *(const f32x4*)sst; S01 = (f32x2){S.x, S.y}; S23 = (f32x2){S.z, S.w}; }
                const int ycol = vcol + wave * 4 + g4;
                const int lo = kq * 16, vo = 1280 + (wave * 4 + g4) * 4;
#define SC_DECL(X) f32x4 X##r, X##w, X##k, X##q, X##b; float X##v
#define SC_LD(X, j) { const LAS unsigned char* rec_ = buf + (j) * (REC * 4); X##r = *(const LAS f32x4*)(rec_ + lo); X##w = *(const LAS f32x4*)(rec_ + 256 + lo); X##k = *(const LAS f32x4*)(rec_ + 512 + lo); \
                      X##q = *(const LAS f32x4*)(rec_ + 768 + lo); X##b = *(const LAS f32x4*)(rec_ + 1024 + lo); X##v = *(const LAS float*)(rec_ + vo); }
#define SC_CP(X, Y) { X##r = Y##r; X##w = Y##w; X##k = Y##k; X##q = Y##q; X##b = Y##b; X##v = Y##v; }
#define LO2(v) ((f32x2){(v).x, (v).y})
#define HI2(v) ((f32x2){(v).z, (v).w})
#define SC_STEP(X, j) { f32x2 ta = S01 * LO2(X##q); ta = S23 * HI2(X##q) + ta; f32x2 tb = S01 * LO2(Pr); tb = S23 * HI2(Pr) + tb; \
                        float sa = ta.x + ta.y, yy = tb.x + tb.y; const f32x2 kv01 = LO2(X##k) * X##v, kv23 = HI2(X##k) * X##v; \
                        sa += dppf(sa, 0); yy += dppf(yy, 0); sa += dppf(sa, 1); yy += dppf(yy, 1); sa += dppf(sa, 2); yy += dppf(yy, 2); sa += dppf(sa, 3); yy += dppf(yy, 3); \
                        if ((j) > 0 && (j) <= 16) yk0 = (kq == (j) - 1) ? yy : yk0; if ((j) > 16) yk1 = (kq == (j) - 17) ? yy : yk1; \
                        S01 = S01 * LO2(X##w) + (kv01 - LO2(X##b) * sa); S23 = S23 * HI2(X##w) + (kv23 - HI2(X##b) * sa); Pr = X##r; }
                for (int c = 0; c < nch; ++c) {
                    LBAR();
                    const LAS unsigned char* buf = lds + (c & 1) * CHBYTES;
                    float yk0 = 0.f, yk1 = 0.f; f32x4 Pr;
                    SC_DECL(C0); SC_DECL(N0);
                    SC_LD(C0, 0);
                    SC_CP(N0, C0); Pr = C0r;
#pragma unroll
                    for (int j = 0; j < CH; ++j) {
                        if (j + 1 < CH) SC_LD(N0, j + 1);
                        SC_STEP(C0, j);
                        SC_CP(C0, N0);
                    }
                    { f32x2 tb = S01 * LO2(Pr); tb = S23 * HI2(Pr) + tb; const float yy = red16(tb.x + tb.y); yk1 = (kq == 15) ? yy : yk1; }
                    const int t0c = c * CH + kq;
                    if (t0c < SEGT) Yr[(size_t)(mrow0 + t0c) * 1024 + ycol] = yk0;
                    if (t0c + 16 < SEGT) Yr[(size_t)(mrow0 + t0c + 16) * 1024 + ycol] = yk1;
                }
#undef SC_DECL
#undef SC_LD
#undef SC_CP
#undef SC_STEP
#undef LO2
#undef HI2
                if (PROBE != 3 || rep_ == 1) *(f32x4*)sst = (f32x4){S01.x, S01.y, S23.x, S23.y};
            }
        } }
        GRID_SYNC();
        REP(4) { DECL_PTRS const bf16* halo_cur = HALO + (size_t)(s & 1) * HALO_PAR;
        if (s > 0) {
            for (int m = gw; m < Mseg; m += NGW) {
                const int lane = opaque(tid) & 63;
                const int b = m >> lgT, i = m & (SEGT - 1), c = 16 * lane; const size_t o = (size_t)m * 1024 + c;
                const bf16* cur = P + (size_t)m * PC; const bf16* pr1 = (i >= 1) ? cur - PC : halo_cur + (size_t)(b * 3 + 2) * PC;
                float y[16], t[16], u[16];
                load16f(Yr + o, y); float sm = 0.f;
#pragma unroll
                for (int j = 0; j < 16; ++j) sm += y[j];
                const float mean = quad_sum(sm) * (1.f / 64.f); float vs = 0.f;
#pragma unroll
                for (int j = 0; j < 16; ++j) { y[j] -= mean; vs += y[j] * y[j]; }
                const float rstd = rsqf_(quad_sum(vs) * (1.f / 64.f) + LNX_EPS);
                load16f(p.ln_w + c, t); load16f(p.ln_b + c, u);
#pragma unroll
                for (int j = 0; j < 16; ++j) y[j] = y[j] * rstd * t[j] + u[j];
                const float bs = SB[(size_t)m * 16 + (lane >> 2)];
                shift16(cur + 2048 + c, pr1 + 2048 + c, p.mu + 2048 + c, t); load16bf(L + (size_t)m * 3072 + 2048 + c, u);
#pragma unroll
                for (int j = 0; j < 16; ++j) y[j] = (y[j] + bs * t[j]) * u[j];
                store16bf(YA + ((size_t)b * SEQ + gbase + i) * 1024 + c, y);
            }
        }
        {
            const int lch = (SEGT < 32) ? SEGT : 32, nlc = SEGT / lch;
            const float* LSTin = LST + (size_t)(s & 1) * (NB * 1024); float* LSTout = LST + (size_t)((s + 1) & 1) * (NB * 1024);
            for (int idx = gtid; idx < NB * nlc * 512; idx += NGT) {
                const int c = 2 * (idx & 511), q = idx >> 9, chunk = q % nlc, b = q / nlc; const size_t m0 = (size_t)b * SEGT + chunk * lch;
                f32x2 hh = *(const f32x2*)(LSTin + b * 1024 + c);
#pragma unroll 16
                for (int k = 0; k < chunk; ++k) { const size_t o = (size_t)(b * 64 + k) * 1024 + c; hh = *(const f32x2*)(CHA + o) * hh + *(const f32x2*)(CHBv + o); }
#pragma unroll 32
                for (int j = 0; j < lch; ++j) {
                    const f32x2 a = *(const f32x2*)(LRA + (m0 + j) * 1024 + c); const unsigned lb = *(const unsigned*)(LRB + (m0 + j) * 1024 + c);
                    const f32x2 bb = {sqrtf_(fmaxf(1.0f - a.x * a.x, 0.f)) * bflo(lb), sqrtf_(fmaxf(1.0f - a.y * a.y, 0.f)) * bfhi(lb)}; hh = a * hh + bb;
                    if (s > 0) { const unsigned yb = *(const unsigned*)(P + (m0 + j) * PC + OFF_YB + c);
                        *(unsigned*)(YB + ((size_t)b * SEQ + gbase + chunk * lch + j) * 1024 + c) = pk2(hh.x * gelu_tanh(bflo(yb)), hh.y * gelu_tanh(bfhi(yb))); }
                }
                if (chunk == nlc - 1 && (PROBE != 4 || rep_ == 1)) *(f32x2*)(LSTout + b * 1024 + c) = hh;
            }
        }
        if (s + 1 < NSEG) {
            for (int m = gw; m < MSEGMAX; m += 4 * NGW) {
                int mr[4]; const float* xr[4]; bf16* orow[4];
#pragma unroll
                for (int r = 0; r < 4; ++r) { mr[r] = (m + r * NGW < MSEGMAX) ? m + r * NGW : m; const int b = mr[r] >> LGSEG, i = mr[r] & (SEGMAX - 1); xr[r] = p.x + ((size_t)b * SEQ + (size_t)s * SEGMAX + i) * D; orow[r] = XN + (size_t)mr[r] * D; }
                rms_rows4_to_bf16(xr[0], xr[1], xr[2], xr[3], p.norm_mix_g, orow[0], orow[1], orow[2], orow[3], opaque(tid) & 63);
            }
        } }
        GRID_SYNC();
    }

    REP(10) { DECL_PTRS OpT1 op{T1, GATES}; run_gemm<OpT1, true>(lds, YA, D, Wpa_t, MT, D, D, 0, 0, op); }
    REP(10) { DECL_PTRS OpMix op{T1, GATES, MIX}; run_gemm<OpMix, true>(lds, YB, D, Wpb_t, MT, D, D, 0, 0, op); }
    { DECL_PTRS const int st_ = opaque(NGT); for (int e = gtid; e < MT; e += st_) CAR[e] = 0.f; }
    GRID_SYNC();
    REP(11) { DECL_PTRS OpH1 op{p.x, p.out, p.norm_ffn_g, XN2, CAR}; run_gemm<OpH1, true>(lds, MIX, D, Wout_t, MT, D, D, 0, 0, op); }
    GRID_SYNC();
    REP(13) { DECL_PTRS OpZ op{Z, CAR}; run_gemm<OpZ, true>(lds, XN2, D, Wup_t, MT, FF, D, 0, 0, op); }
    GRID_SYNC();
    { DECL_PTRS OpAcc op{p.out}; run_gemm<OpAcc, true>(lds, Z, FF, Wdn_t, MT, D, FF, 0, 0, op); }
    GRID_SYNC();
    for (int m = gw; m < MT; m += 4 * NGW) {
        const int lane = opaque(tid) & 63;
        float* rows[4]; f32x4 v[4][4];
#pragma unroll
        for (int r = 0; r < 4; ++r) { const int mr = (m + r * NGW < MT) ? m + r * NGW : m; rows[r] = p.out + (size_t)mr * D;
#pragma unroll
            for (int j = 0; j < 4; ++j) v[r][j] = *((const f32x4*)rows[r] + lane + 64 * j); }
        f32x4 gg[4];
#pragma unroll
        for (int j = 0; j < 4; ++j) gg[j] = *((const f32x4*)p.norm_final_g + lane + 64 * j);
#pragma unroll
        for (int r = 0; r < 4; ++r) {
            float sq = 0.f;
#pragma unroll
            for (int j = 0; j < 4; ++j) sq += (v[r][j].x * v[r][j].x + v[r][j].y * v[r][j].y) + (v[r][j].z * v[r][j].z + v[r][j].w * v[r][j].w);
            const float sc = rsqf_(wave_sum(sq) * (1.f / D) + RMS_EPS);
            if (r == 0 || m + r * NGW < MT) {
#pragma unroll
                for (int j = 0; j < 4; ++j) *((f32x4*)rows[r] + lane + 64 * j) = v[r][j] * sc * gg[j];
            }
        }
    }
    if (PROBE == 1) { for (int i = 0; i < 40; ++i) GRID_SYNC(); }
}

extern "C" void kernel_launch(void* const* d_in, const int* in_sizes, int n_in, void* d_out, int out_size, void* d_ws, size_t ws_size, hipStream_t stream) {
    static int grid_blocks = 0;
    if (grid_blocks == 0) {
        if (n_in != 29 || ws_size < WS_TAIL_END) { fprintf(stderr, "kernel_launch: unexpected n_in %d or ws_size %zu (< %zu)\n", n_in, ws_size, (size_t)WS_END); grid_blocks = -1; return; }
        int dev = 0, cus = 0, per_cu = 0;
        hipGetDevice(&dev);
        hipDeviceGetAttribute(&cus, hipDeviceAttributeMultiprocessorCount, dev);
        hipFuncSetAttribute((const void*)fwd_megakernel, hipFuncAttributeMaxDynamicSharedMemorySize, LDS_BYTES);
        hipOccupancyMaxActiveBlocksPerMultiprocessor(&per_cu, (const void*)fwd_megakernel, 512, LDS_BYTES);
        if (per_cu < 1) per_cu = 1;
        grid_blocks = cus * per_cu;
        (void)hipGetLastError();
    }
    if (grid_blocks < 0) return;
    Params p{};
    const float** f = (const float**)&p;
    for (int i = 0; i < 29; ++i) f[i] = (const float*)d_in[i];
    p.out = (float*)d_out; p.ws = (unsigned char*)d_ws;
    void* args[] = {&p};
    hipError_t e = hipLaunchCooperativeKernel((const void*)fwd_megakernel, dim3(grid_blocks), dim3(512), args, LDS_BYTES, stream);
    if (e != hipSuccess) fprintf(stderr, "cooperative launch failed: %s (grid %d)\n", hipGetErrorString(e), grid_blocks);
}
```

```cpp
#include <hip/hip_runtime.h>
#include <hip/hip_cooperative_groups.h>
#include <cstdio>
#include <cstdint>
namespace cg = cooperative_groups;

#define GAS __attribute__((address_space(1)))
#define LAS __attribute__((address_space(3)))
typedef unsigned short bf16;
typedef unsigned v4u __attribute__((ext_vector_type(4)));
typedef unsigned v2u __attribute__((ext_vector_type(2)));
typedef float f32x4 __attribute__((ext_vector_type(4)));
typedef float f32x2 __attribute__((ext_vector_type(2)));
typedef short bf16x8 __attribute__((ext_vector_type(8)));

namespace pg8 {
constexpr int BM = 256, BK = 64, HALF = 128, HTB = HALF * BK * 2, STAGE_BYTES = 8 * HTB, NXCD = 8, WGM = 8;
__host__ __device__ __forceinline__ int lds_byte(int r, int c) { const int st = (r >> 4) * 2 + (c >> 5), rr = r & 15, cc = c & 31, ob = rr * 64 + cc * 2; return st * 1024 + (ob ^ (((ob >> 9) & 1) << 5)); }
__host__ __device__ __forceinline__ void stage_rc(int b, int& R, int& C) { const int st = b / 1024, sb = b % 1024, swz = sb ^ (((sb >> 9) & 1) << 5); R = (st >> 1) * 16 + swz / 64; C = (st & 1) * 32 + (swz % 64) / 2; }
__host__ __device__ __forceinline__ int perm32(int rho) { const int n = rho >> 4, i = rho & 15; return 8 * (i >> 2) + 4 * n + (i & 3); }
struct Unit { int pm, pn; };
struct Gemm { const bf16* A; const bf16* Bt; int M, N, K, lda, ash, amul; };
struct StaticOrder {
    int nM, nN, nwg, G, c;
    __host__ __device__ void init(int M, int N, int G_, int c_) { nM = M / BM; nN = N / BM; nwg = nM * nN; G = G_; c = c_; }
    __host__ __device__ bool next(int i, Unit& u) const {
        const long L = (long)i * G + c; if (L >= nwg) return false;
        int wgid = (int)L; { const int q = nwg / NXCD, r = nwg % NXCD, xcd = wgid % NXCD, off = wgid / NXCD; wgid = (xcd < r ? xcd * (q + 1) : r * (q + 1) + (xcd - r) * q) + off; }
        const int nig = WGM * nN, gid = wgid / nig, fm = gid * WGM, gsz = (nM - fm) < WGM ? (nM - fm) : WGM;
        u.pm = fm + ((wgid % nig) % gsz); u.pn = (wgid % nig) / gsz; return true;
    }
};
template <class Op> struct EpiOp {
    static constexpr bool PERM = true;
    Op op;
    __device__ __forceinline__ void operator()(const f32x4 (&acc)[2][2][4][2], const Unit& u, int wr, int wc, int fr, int fq) const {
        int row0 = u.pm * BM + wr * 64 + fr, col0 = u.pn * BM + wc * 32 + 8 * fq;
        asm volatile("" : "+v"(row0), "+v"(col0));
#pragma unroll
        for (int ai = 0; ai < 2; ++ai)
#pragma unroll
            for (int m = 0; m < 4; ++m)
                { op(row0 + ai * HALF + m * 16, col0, acc[ai][0][m][0], acc[ai][0][m][1]); op(row0 + ai * HALF + m * 16, col0 + HALF, acc[ai][1][m][0], acc[ai][1][m][1]); asm volatile("" ::: "memory"); }
    }
};

template <class Epi, class Sched, bool ALIGN_EPI>
__device__ __forceinline__ void gemm_phase(LAS unsigned char* lds, const Gemm g, const Sched& S, const Epi& E) {
    int tid = threadIdx.x; asm volatile("" : "+v"(tid));
    const int wid = __builtin_amdgcn_readfirstlane(tid >> 6), lane = tid & 63, wr = wid >> 2, wc = wid & 3, fr = lane & 15, fq = lane >> 4;
    const int K = g.K, nt = K / BK;
    unsigned voffA[2], voffB[2];
#pragma unroll
    for (int i = 0; i < 2; ++i) { int R, C; stage_rc(tid * 16 + i * 8192, R, C); const int Rb = Epi::PERM ? ((R & ~31) + perm32(R & 31)) : R;
        voffA[i] = (unsigned)(R * g.lda + C) * 2u; voffB[i] = (unsigned)(Rb * K + C) * 2u; }
    const size_t kstep = (size_t)(BK * 2);
    const size_t hstepA = (size_t)HALF * g.lda * 2, hstepB = (size_t)HALF * K * 2;
    const size_t tstepA = 2 * hstepA, tstepB = 2 * hstepB;
    const unsigned ldsw = (unsigned)wid * 1024u;
    const int aoff = lds_byte(wr * 64 + fr, fq * 8), boff = lds_byte(wc * 32 + fr, fq * 8);
#define PG8_SA(b, h) (((b) * 2 + (h)) * HTB)
#define PG8_SB(b, h) ((4 + (b) * 2 + (h)) * HTB)
#define PG8_STAGE(bufoff, gbase, voff) do { _Pragma("unroll") for (int _i = 0; _i < 2; ++_i) \
        __builtin_amdgcn_global_load_lds((const unsigned*)((const char*)(gbase) + (voff)[_i]), (LAS unsigned*)(lds + (bufoff) + ldsw + _i * 8192), 16, 0, 0); } while (0)
#define PG8_LDA(dst, b, h) do { _Pragma("unroll") for (int m = 0; m < 4; ++m) _Pragma("unroll") for (int k = 0; k < 2; ++k) dst[m][k] = *(const LAS bf16x8*)(lds + PG8_SA(b, h) + aoff + m * 2048 + k * 1024); } while (0)
#define PG8_LDB(dst, b, h) do { _Pragma("unroll") for (int n = 0; n < 2; ++n) _Pragma("unroll") for (int k = 0; k < 2; ++k) dst[n][k] = *(const LAS bf16x8*)(lds + PG8_SB(b, h) + boff + n * 2048 + k * 1024); } while (0)
#define PG8_MMA(ai, bj, At, Bt) do { __builtin_amdgcn_s_setprio(1); _Pragma("unroll") for (int m = 0; m < 4; ++m) _Pragma("unroll") for (int n = 0; n < 2; ++n) _Pragma("unroll") for (int k = 0; k < 2; ++k) \
        acc[ai][bj][m][n] = __builtin_amdgcn_mfma_f32_16x16x32_bf16(Bt[n][k], At[m][k], acc[ai][bj][m][n], 0, 0, 0); __builtin_amdgcn_s_setprio(0); } while (0)
#define PG8_WAIT_V(n) asm volatile("s_waitcnt vmcnt(" #n ")" ::: "memory")
#define PG8_WAIT_L(n) asm volatile("s_waitcnt lgkmcnt(" #n ")" ::: "memory")
#define PG8_BAR __builtin_amdgcn_s_barrier()
#define PG8_SCHED __builtin_amdgcn_sched_barrier(0)
#define PG8_UA(u) ((const char*)g.A + (size_t)(u).pm * tstepA + (size_t)(((u).pn >> g.ash) * g.amul) * 2)
#define PG8_UB(u) ((const char*)g.Bt + (size_t)(u).pn * tstepB)
    Unit cur, nxt; int ui = 0;
    if (!S.next(0, cur)) return;
    f32x4 acc[2][2][4][2];
#pragma unroll
    for (int a = 0; a < 2; ++a)
#pragma unroll
        for (int b = 0; b < 2; ++b)
#pragma unroll
            for (int m = 0; m < 4; ++m)
#pragma unroll
                for (int n = 0; n < 2; ++n) acc[a][b][m][n] = (f32x4){0.f, 0.f, 0.f, 0.f};
    bf16x8 At[4][2], B0[2][2], B1[2][2];
    const char* cA = PG8_UA(cur); const char* cB = PG8_UB(cur);
    PG8_STAGE(PG8_SB(0, 0), cB, voffB); PG8_STAGE(PG8_SB(0, 1), cB + hstepB, voffB); PG8_STAGE(PG8_SA(0, 0), cA, voffA); PG8_STAGE(PG8_SA(0, 1), cA + hstepA, voffA);
    if (wr == 1) PG8_BAR;
    PG8_WAIT_V(2); PG8_BAR;
    PG8_STAGE(PG8_SB(1, 0), cB + kstep, voffB); PG8_STAGE(PG8_SA(1, 0), cA + kstep, voffA); PG8_STAGE(PG8_SB(1, 1), cB + hstepB + kstep, voffB);
    PG8_WAIT_V(6); PG8_BAR;
    for (;;) {
        const bool has_next = S.next(ui + 1, nxt);
        const char* nA = has_next ? PG8_UA(nxt) : cA; const char* nB = has_next ? PG8_UB(nxt) : cB;
        for (int t = 0; t < nt; t += 2) {
            const bool last = (t == nt - 2);
            const char* a1 = cA + (size_t)(t + 1) * kstep;
            const char* a2 = last ? nA : cA + (size_t)(t + 2) * kstep; const char* b2 = last ? nB : cB + (size_t)(t + 2) * kstep;
            const char* a3 = a2 + kstep; const char* b3 = b2 + kstep;
            PG8_LDB(B0, 0, 0); PG8_LDB(B1, 0, 1); PG8_SCHED; PG8_LDA(At, 0, 0); PG8_STAGE(PG8_SA(1, 1), a1 + hstepA, voffA);
            PG8_WAIT_V(8); PG8_WAIT_L(0); PG8_BAR; PG8_MMA(0, 0, At, B0); PG8_MMA(0, 1, At, B1); PG8_BAR; PG8_SCHED;
            PG8_LDA(At, 0, 1); PG8_STAGE(PG8_SB(0, 0), b2, voffB); PG8_STAGE(PG8_SB(0, 1), b2 + hstepB, voffB); PG8_STAGE(PG8_SA(0, 0), a2, voffA);
            PG8_WAIT_V(8); PG8_WAIT_L(0); PG8_BAR; PG8_MMA(1, 0, At, B0); PG8_MMA(1, 1, At, B1); PG8_BAR; PG8_SCHED;
            PG8_LDB(B0, 1, 0); PG8_LDB(B1, 1, 1); PG8_SCHED; PG8_LDA(At, 1, 0); PG8_STAGE(PG8_SA(0, 1), a2 + hstepA, voffA);
            PG8_WAIT_V(8); PG8_WAIT_L(0); PG8_BAR; PG8_MMA(0, 0, At, B0); PG8_MMA(0, 1, At, B1); PG8_BAR; PG8_SCHED;
            PG8_LDA(At, 1, 1); PG8_STAGE(PG8_SB(1, 0), b3, voffB); PG8_STAGE(PG8_SB(1, 1), b3 + hstepB, voffB); PG8_STAGE(PG8_SA(1, 0), a3, voffA);
            PG8_WAIT_V(8); PG8_WAIT_L(0); PG8_BAR; PG8_MMA(1, 0, At, B0); PG8_MMA(1, 1, At, B1); PG8_BAR; PG8_SCHED;
        }
        if constexpr (ALIGN_EPI) { if (wr == 0) PG8_BAR; }
        E(acc, cur, wr, wc, fr, fq);
        if (!has_next) break;
#pragma unroll
        for (int a = 0; a < 2; ++a)
#pragma unroll
            for (int b = 0; b < 2; ++b)
#pragma unroll
                for (int m = 0; m < 4; ++m)
#pragma unroll
                    for (int n = 0; n < 2; ++n) acc[a][b][m][n] = (f32x4){0.f, 0.f, 0.f, 0.f};
        cur = nxt; cA = nA; cB = nB; ++ui;
        if constexpr (ALIGN_EPI) { if (wr == 1) PG8_BAR; }
    }
    PG8_WAIT_V(0);
    if constexpr (!ALIGN_EPI) { if (wr == 0) PG8_BAR; }
    PG8_BAR;
#undef PG8_SA
#undef PG8_SB
#undef PG8_STAGE
#undef PG8_LDA
#undef PG8_LDB
#undef PG8_MMA
#undef PG8_WAIT_V
#undef PG8_WAIT_L
#undef PG8_BAR
#undef PG8_SCHED
#undef PG8_UA
#undef PG8_UB
}
}

constexpr int NB = 4, TT = 8208, NMETA = 16, SEQ = 8192, D = 1024, NCOL = 7424, PC = 5376, FF = 4096, NH = 16;
constexpr int MT = NB * SEQ;
constexpr int LGSEG = 11, SEGMAX = 1 << LGSEG, MSEGMAX = NB * SEGMAX;
constexpr int NSEG = 1 + SEQ / SEGMAX;
constexpr int OFF_WD = 3072, OFF_XB = 3328, OFF_YB = 4352;
constexpr float RMS_EPS = 1e-6f, LNX_EPS = 64e-5f;

constexpr size_t MiB = 1u << 20;
constexpr size_t WS_BAR = 4 * MiB + 131072;
constexpr size_t WS_SST = 0 * MiB, WS_CHA = 1 * MiB, WS_CHB = 2 * MiB, WS_CAR = 3 * MiB, WS_LST = 4 * MiB, WS_CL = 4 * MiB + 65536;
constexpr size_t WS_WIN = 5 * MiB, WS_WPA = 20 * MiB, WS_WPB = 22 * MiB, WS_WOUT = 24 * MiB, WS_WUP = 26 * MiB, WS_WDN = 34 * MiB, WS_WLORA = 42 * MiB, WS_WLRU = 43 * MiB;
constexpr size_t WS_YA = 44 * MiB, WS_YB = 108 * MiB;
constexpr size_t WS_XN = 172 * MiB, WS_P = 188 * MiB, WS_HALO = 272 * MiB, WS_LA = 273 * MiB, WS_XC = 277 * MiB, WS_L = 293 * MiB, WS_LRA = 341 * MiB, WS_LRB = 373 * MiB;
constexpr size_t WS_R = 389 * MiB  , WS_Y = 390 * MiB, WS_END = 422 * MiB;
static_assert(WS_XN + (size_t)MSEGMAX * D * 2 <= WS_P && WS_P + (size_t)MSEGMAX * PC * 2 <= WS_HALO && WS_LA + (size_t)MSEGMAX * 256 * 2 <= WS_XC && WS_XC + (size_t)MSEGMAX * 1024 * 2 <= WS_L && WS_L + (size_t)MSEGMAX * 3072 * 2 <= WS_LRA && WS_LRA + (size_t)MSEGMAX * 1024 * 4 <= WS_LRB && WS_LRB + (size_t)MSEGMAX * 1024 * 2 <= WS_R && WS_Y + (size_t)MSEGMAX * 1024 * 4 <= WS_END, "segment buffers");
constexpr size_t WS_T1 = 172 * MiB, WS_MIX = 300 * MiB, WS_XN2 = 364 * MiB, WS_Z = 44 * MiB, WS_TAIL_END = 428 * MiB;
constexpr int LDS_BYTES = 135168;

struct Params {
    const float *x, *meta, *norm_mix_g, *w_in, *mu, *w0, *w_decay_up, *a0, *w_aaa_up, *w_gate_up, *k_k, *k_a, *r_k, *ln_w, *ln_b, *w_proj_a, *conv_w, *conv_b,
        *lru_wa, *lru_ba, *lru_wx, *lru_bx, *lru_lambda, *w_proj_b, *w_out, *norm_ffn_g, *w_ff_up, *w_ff_down, *norm_final_g;
    float* out; unsigned char* ws;
};

__device__ __forceinline__ int opaque(int x) { asm volatile("" : "+v"(x)); return x; }
__device__ __forceinline__ unsigned f2bf(float f) { unsigned u = __builtin_bit_cast(unsigned, f); return (u + 0x7fffu + ((u >> 16) & 1u)) >> 16; }
__device__ __forceinline__ unsigned pk2(float lo, float hi) { unsigned r; asm("v_cvt_pk_bf16_f32 %0, %1, %2" : "=v"(r) : "v"(lo), "v"(hi)); return r; }
__device__ __forceinline__ float bflo(unsigned w) { return __builtin_bit_cast(float, w << 16); }
__device__ __forceinline__ float bfhi(unsigned w) { return __builtin_bit_cast(float, w & 0xffff0000u); }
__device__ __forceinline__ float bf1(bf16 h) { return __builtin_bit_cast(float, (unsigned)h << 16); }
__device__ __forceinline__ float rcpf_(float x) { return __builtin_amdgcn_rcpf(x); }
__device__ __forceinline__ float rsqf_(float x) { return __builtin_amdgcn_rsqf(x); }
__device__ __forceinline__ float sqrtf_(float x) { return __builtin_amdgcn_sqrtf(x); }
__device__ __forceinline__ float sigmoidf_(float x) { return rcpf_(1.0f + __expf(-x)); }
__device__ __forceinline__ float tanhf_(float x) { return 1.0f - 2.0f * rcpf_(__expf(2.0f * x) + 1.0f); }
__device__ __forceinline__ float gelu_tanh(float x) { return 0.5f * x * (1.0f + tanhf_(0.7978845608028654f * (x + 0.044715f * x * x * x))); }
__device__ __forceinline__ v4u pack8(f32x4 a, f32x4 b) { v4u w; w.x = pk2(a.x, a.y); w.y = pk2(a.z, a.w); w.z = pk2(b.x, b.y); w.w = pk2(b.z, b.w); return w; }
__device__ __forceinline__ void unpack8(v4u w, float* o) { o[0] = bflo(w.x); o[1] = bfhi(w.x); o[2] = bflo(w.y); o[3] = bfhi(w.y); o[4] = bflo(w.z); o[5] = bfhi(w.z); o[6] = bflo(w.w); o[7] = bfhi(w.w); }
template <int CTRL> __device__ __forceinline__ float dppx(float v) { return __builtin_bit_cast(float, __builtin_amdgcn_update_dpp(0, __builtin_bit_cast(int, v), CTRL, 0xf, 0xf, true)); }
__device__ __forceinline__ float wave_sum(float v) {
    v += dppx<0xB1>(v); v += dppx<0x4E>(v); v += dppx<0x141>(v); v += dppx<0x140>(v);
    v += __shfl_xor(v, 16); v += __shfl_xor(v, 32);
    return v;
}
__device__ __forceinline__ float quad_sum(float v) { v += dppx<0xB1>(v); v += dppx<0x4E>(v); return v; }
__device__ __forceinline__ void load16bf(const bf16* p, float* o) { const v4u a = *(const v4u*)p, b = *(const v4u*)(p + 8); unpack8(a, o); unpack8(b, o + 8); }
__device__ __forceinline__ void load16f(const float* p, float* o) {
#pragma unroll
    for (int j = 0; j < 4; ++j) { const f32x4 v = *(const f32x4*)(p + 4 * j); o[4 * j] = v.x; o[4 * j + 1] = v.y; o[4 * j + 2] = v.z; o[4 * j + 3] = v.w; }
}
__device__ __forceinline__ void store16f(float* p, const float* o) {
#pragma unroll
    for (int j = 0; j < 4; ++j) *(f32x4*)(p + 4 * j) = (f32x4){o[4 * j], o[4 * j + 1], o[4 * j + 2], o[4 * j + 3]};
}
__device__ __forceinline__ void store16bf(bf16* p, const float* o) {
    v4u a, b; a.x = pk2(o[0], o[1]); a.y = pk2(o[2], o[3]); a.z = pk2(o[4], o[5]); a.w = pk2(o[6], o[7]); b.x = pk2(o[8], o[9]); b.y = pk2(o[10], o[11]); b.z = pk2(o[12], o[13]); b.w = pk2(o[14], o[15]);
    *(v4u*)p = a; *(v4u*)(p + 8) = b;
}
__device__ __forceinline__ void shift16(const bf16* cur, const bf16* prev, const float* mu, float* o) {
    float c[16], q[16], m[16]; load16bf(cur, c); load16bf(prev, q); load16f(mu, m);
#pragma unroll
    for (int j = 0; j < 16; ++j) o[j] = c[j] + (q[j] - c[j]) * m[j];
}

__device__ __forceinline__ void transpose_item(const float* W, int K, int N, bf16* WT, LAS float* scr, int item, int lane) {
    const int nblk = N / 32, kb = item / nblk, nb = item % nblk, k0 = 64 * kb, n0 = 32 * nb;
    float wv[32];
#pragma unroll
    for (int i = 0; i < 32; ++i) wv[i] = W[(size_t)(k0 + 2 * i + (lane >> 5)) * N + n0 + (lane & 31)];
#pragma unroll
    for (int i = 0; i < 32; ++i) scr[(2 * i + (lane >> 5)) * 33 + (lane & 31)] = wv[i];
    asm volatile("s_waitcnt lgkmcnt(0)" ::: "memory");
    const int c = lane & 7;
#pragma unroll
    for (int j = 0; j < 4; ++j) { const int n = (lane >> 3) + 8 * j; const LAS float* s = scr + (8 * c) * 33 + n;
        v4u o; o.x = pk2(s[0 * 33], s[1 * 33]); o.y = pk2(s[2 * 33], s[3 * 33]); o.z = pk2(s[4 * 33], s[5 * 33]); o.w = pk2(s[6 * 33], s[7 * 33]);
        *(v4u*)(WT + (size_t)(n0 + n) * K + k0 + 8 * c) = o; }
    asm volatile("s_waitcnt lgkmcnt(0)" ::: "memory");
}
__device__ __forceinline__ void rms_row_to_bf16(const float* xrow, const float* g, bf16* orow, int lane) {
    f32x4 v[4]; float s = 0.f;
#pragma unroll
    for (int j = 0; j < 4; ++j) { v[j] = *((const f32x4*)xrow + lane + 64 * j); s += (v[j].x * v[j].x + v[j].y * v[j].y) + (v[j].z * v[j].z + v[j].w * v[j].w); }
    const float sc = rsqf_(wave_sum(s) * (1.f / D) + RMS_EPS);
#pragma unroll
    for (int j = 0; j < 4; ++j) { const f32x4 gg = *((const f32x4*)g + lane + 64 * j); v2u o; o.x = pk2(v[j].x * sc * gg.x, v[j].y * sc * gg.y); o.y = pk2(v[j].z * sc * gg.z, v[j].w * sc * gg.w);
        *((v2u*)orow + lane + 64 * j) = o; }
}

__device__ __forceinline__ void rms_rows4_to_bf16(const float* x0, const float* x1, const float* x2, const float* x3, const float* g, bf16* o0, bf16* o1, bf16* o2, bf16* o3, int lane) {
    const float* xs[4] = {x0, x1, x2, x3}; bf16* os[4] = {o0, o1, o2, o3};
    f32x4 v[4][4];
#pragma unroll
    for (int r = 0; r < 4; ++r)
#pragma unroll
        for (int j = 0; j < 4; ++j) v[r][j] = *((const f32x4*)xs[r] + lane + 64 * j);
    f32x4 gg[4];
#pragma unroll
    for (int j = 0; j < 4; ++j) gg[j] = *((const f32x4*)g + lane + 64 * j);
#pragma unroll
    for (int r = 0; r < 4; ++r) {
        float s = 0.f;
#pragma unroll
        for (int j = 0; j < 4; ++j) s += (v[r][j].x * v[r][j].x + v[r][j].y * v[r][j].y) + (v[r][j].z * v[r][j].z + v[r][j].w * v[r][j].w);
        const float sc = rsqf_(wave_sum(s) * (1.f / D) + RMS_EPS);
#pragma unroll
        for (int j = 0; j < 4; ++j) { v2u o; o.x = pk2(v[r][j].x * sc * gg[j].x, v[r][j].y * sc * gg[j].y); o.y = pk2(v[r][j].z * sc * gg[j].z, v[r][j].w * sc * gg[j].w); *((v2u*)os[r] + lane + 64 * j) = o; }
    }
}

struct OpP {
    bf16* P; bf16* halo_next; bf16* gates; int Mseg, lgT, gbase, s;
    __device__ __forceinline__ void operator()(int row, int col, f32x4 v0, f32x4 v1) const {
        if (row >= Mseg) return;
        const v4u w = pack8(v0, v1); const int b = row >> lgT, SEGT = 1 << lgT, i = row & (SEGT - 1);
        if (col < PC) {
            *(v4u*)(P + (size_t)row * PC + col) = w;
            if (i >= SEGT - 3) *(v4u*)(halo_next + (size_t)(b * 3 + (i - (SEGT - 3))) * PC + col) = w;
        } else if (s > 0) {
            *(v4u*)(gates + ((size_t)b * SEQ + gbase + i) * 2048 + (col - PC)) = w;
        }
    }
};
struct OpLora {
    bf16* L; int Mseg;
    __device__ __forceinline__ void operator()(int row, int col, f32x4 v0, f32x4 v1) const {
        if (row >= Mseg) return;
        *(v4u*)(L + (size_t)row * 3072 + col) = pack8(v0, v1);
    }
};
struct OpLru {
    float* LRA; bf16* LRB; const bf16* XC; const float* CL; const float* ba; const float* bx; int Mseg;
    __device__ __forceinline__ void operator()(int row, int col, f32x4 v0, f32x4 v1) const {
        if (row >= Mseg) return;
        float v[8] = {v0.x, v0.y, v0.z, v0.w, v1.x, v1.y, v1.z, v1.w};
        const int pj = col >> 8, nn = col & 255, blk = nn >> 7, gate = (nn >> 6) & 1, j = nn & 63, ch = 64 * (2 * pj + blk) + j;
        if (gate == 0) {
            float cl[8], bb[8]; { const f32x4 c0 = *(const f32x4*)(CL + ch), c1 = *(const f32x4*)(CL + ch + 4), b0 = *(const f32x4*)(ba + ch), b1 = *(const f32x4*)(ba + ch + 4);
                cl[0] = c0.x; cl[1] = c0.y; cl[2] = c0.z; cl[3] = c0.w; cl[4] = c1.x; cl[5] = c1.y; cl[6] = c1.z; cl[7] = c1.w; bb[0] = b0.x; bb[1] = b0.y; bb[2] = b0.z; bb[3] = b0.w; bb[4] = b1.x; bb[5] = b1.y; bb[6] = b1.z; bb[7] = b1.w; }
#pragma unroll
            for (int e = 0; e < 8; ++e) v[e] = __expf(cl[e] * sigmoidf_(v[e] + bb[e]));
            float* o = LRA + (size_t)row * 1024 + ch;
            *(f32x4*)o = (f32x4){v[0], v[1], v[2], v[3]}; *(f32x4*)(o + 4) = (f32x4){v[4], v[5], v[6], v[7]};
        } else {
            float xc[8]; unpack8(*(const v4u*)(XC + (size_t)row * 1024 + ch), xc);
            float bb[8]; { const f32x4 b0 = *(const f32x4*)(bx + ch), b1 = *(const f32x4*)(bx + ch + 4); bb[0] = b0.x; bb[1] = b0.y; bb[2] = b0.z; bb[3] = b0.w; bb[4] = b1.x; bb[5] = b1.y; bb[6] = b1.z; bb[7] = b1.w; }
#pragma unroll
            for (int e = 0; e < 8; ++e) v[e] = sigmoidf_(v[e] + bb[e]) * xc[e];
            *(v4u*)(LRB + (size_t)row * 1024 + ch) = pack8((f32x4){v[0], v[1], v[2], v[3]}, (f32x4){v[4], v[5], v[6], v[7]});
        }
    }
};
struct OpT1 {
    bf16* T1; const bf16* gates;
    __device__ __forceinline__ void operator()(int row, int col, f32x4 v0, f32x4 v1) const {
        float gt[8]; unpack8(*(const v4u*)(gates + (size_t)row * 2048 + col), gt);
        const f32x4 a = {sigmoidf_(gt[0]) * v0.x, sigmoidf_(gt[1]) * v0.y, sigmoidf_(gt[2]) * v0.z, sigmoidf_(gt[3]) * v0.w};
        const f32x4 b = {sigmoidf_(gt[4]) * v1.x, sigmoidf_(gt[5]) * v1.y, sigmoidf_(gt[6]) * v1.z, sigmoidf_(gt[7]) * v1.w};
        *(v4u*)(T1 + (size_t)row * 1024 + col) = pack8(a, b);
    }
};
struct OpMix {
    const bf16* T1; const bf16* gates; bf16* MIX;
    __device__ __forceinline__ void operator()(int row, int col, f32x4 v0, f32x4 v1) const {
        float gt[8], t[8]; unpack8(*(const v4u*)(gates + (size_t)row * 2048 + 1024 + col), gt); unpack8(*(const v4u*)(T1 + (size_t)row * 1024 + col), t);
        const f32x4 a = {t[0] + sigmoidf_(gt[0]) * v0.x, t[1] + sigmoidf_(gt[1]) * v0.y, t[2] + sigmoidf_(gt[2]) * v0.z, t[3] + sigmoidf_(gt[3]) * v0.w};
        const f32x4 b = {t[4] + sigmoidf_(gt[4]) * v1.x, t[5] + sigmoidf_(gt[5]) * v1.y, t[6] + sigmoidf_(gt[6]) * v1.z, t[7] + sigmoidf_(gt[7]) * v1.w};
        *(v4u*)(MIX + (size_t)row * 1024 + col) = pack8(a, b);
    }
};
struct OpH1 {
    const float* x; float* out; const float* gff; bf16* XN2; float* SS;
    __device__ __forceinline__ void operator()(int row, int col, f32x4 v0, f32x4 v1) const {
        const size_t o = (size_t)row * 1024 + col; const f32x4 a = *(const f32x4*)(x + o) + v0, b = *(const f32x4*)(x + o + 4) + v1;
        *(f32x4*)(out + o) = a; *(f32x4*)(out + o + 4) = b;
        const f32x4 g0 = *(const f32x4*)(gff + col), g1 = *(const f32x4*)(gff + col + 4);
        *(v4u*)(XN2 + o) = pack8(a * g0, b * g1);
        float ss = (a.x * a.x + a.y * a.y) + (a.z * a.z + a.w * a.w) + (b.x * b.x + b.y * b.y) + (b.z * b.z + b.w * b.w);
        ss += __shfl_xor(ss, 16); ss += __shfl_xor(ss, 32);
        if ((threadIdx.x & 63) < 16) atomicAdd(SS + row, ss);
    }
};
struct OpZ {
    bf16* Z; const float* SS;
    __device__ __forceinline__ void operator()(int row, int col, f32x4 v0, f32x4 v1) const {
        const float rs = rsqf_(SS[row] * (1.f / D) + RMS_EPS);
        f32x4 a, b;
        a.x = fmaxf(v0.x, 0.f); a.y = fmaxf(v0.y, 0.f); a.z = fmaxf(v0.z, 0.f); a.w = fmaxf(v0.w, 0.f); b.x = fmaxf(v1.x, 0.f); b.y = fmaxf(v1.y, 0.f); b.z = fmaxf(v1.z, 0.f); b.w = fmaxf(v1.w, 0.f);
        a = a * rs; b = b * rs;
        *(v4u*)(Z + (size_t)row * FF + col) = pack8(a * a, b * b);
    }
};
struct OpAcc {
    float* out;
    __device__ __forceinline__ void operator()(int row, int col, f32x4 v0, f32x4 v1) const {
        float* o = out + (size_t)row * 1024 + col; const f32x4 a = *(const f32x4*)o, b = *(const f32x4*)(o + 4);
        *(f32x4*)o = a + v0; *(f32x4*)(o + 4) = b + v1;
    }
};
template <class Op, bool ALIGN>
__device__ __forceinline__ void run_gemm(LAS unsigned char* lds, const bf16* A, int lda, const bf16* Bt, int M, int N, int K, int ash, int amul, const Op& op) {
    pg8::Gemm g{A, Bt, M, N, K, lda, ash, amul}; pg8::StaticOrder S; S.init(M, N, (int)gridDim.x, (int)blockIdx.x);
    pg8::EpiOp<Op> E{op};
    pg8::gemm_phase<pg8::EpiOp<Op>, pg8::StaticOrder, ALIGN>(lds, g, S, E);
}

constexpr int CH = 32, REC = 336  , CHBYTES = CH * REC * 4;
__device__ __forceinline__ float dppf(float v, const int ctrl_sel) {
    const int x = __builtin_bit_cast(int, v); int r;
    if (ctrl_sel == 0) r = __builtin_amdgcn_update_dpp(0, x, 0xB1, 0xf, 0xf, true);
    else if (ctrl_sel == 1) r = __builtin_amdgcn_update_dpp(0, x, 0x4E, 0xf, 0xf, true);
    else if (ctrl_sel == 2) r = __builtin_amdgcn_update_dpp(0, x, 0x141, 0xf, 0xf, true);
    else r = __builtin_amdgcn_update_dpp(0, x, 0x140, 0xf, 0xf, true);
    return __builtin_bit_cast(float, r);
}
__device__ __forceinline__ float red16(float v) { v += dppf(v, 0); v += dppf(v, 1); v += dppf(v, 2); v += dppf(v, 3); return v; }

__device__ __forceinline__ float red32(float v) {
    v = red16(v); float a = v, b = v;
    asm volatile("s_nop 1\n\tv_permlane16_swap_b32 %0, %1" : "+v"(a), "+v"(b));
    return a + b;
}
struct ScanRegs { f32x4 a[5]; f32x4 v; };
__device__ __forceinline__ void scan_load(ScanRegs& R, const float* const* arr, const float* V, int mrow, int hcol, int vcol, int pt) {
    const int j = pt >> 4, q = pt & 15;
#pragma unroll
    for (int a = 0; a < 5; ++a) R.a[a] = *(const f32x4*)(arr[a] + (size_t)(mrow + j) * 1024 + hcol + 4 * q);
    R.v = *(const f32x4*)(V + (size_t)(mrow + ((pt & 63) >> 2)) * 1024 + vcol + 4 * (pt & 3));
}
__device__ __forceinline__ void scan_write(const ScanRegs& R, LAS unsigned char* buf, int pt) {
    const int j = pt >> 4, q = pt & 15;
#pragma unroll
    for (int a = 0; a < 5; ++a) *(LAS f32x4*)(buf + j * (REC * 4) + a * 256 + q * 16) = R.a[a];
    if (pt < 64) *(LAS f32x4*)(buf + (pt >> 2) * (REC * 4) + 1280 + (pt & 3) * 16) = R.v;
}

#define DECL_PTRS \
    GAS unsigned char* wsg_ = (GAS unsigned char*)p.ws; asm volatile("" : "+s"(wsg_)); unsigned char* ws = (unsigned char*)wsg_;     \
    float* SST = (float*)(ws + WS_SST); float* CHA = (float*)(ws + WS_CHA); float* CHBv = (float*)(ws + WS_CHB); float* CAR = (float*)(ws + WS_CAR); float* LST = (float*)(ws + WS_LST); float* CL = (float*)(ws + WS_CL); \
    bf16* Win_t = (bf16*)(ws + WS_WIN); bf16* Wpa_t = (bf16*)(ws + WS_WPA); bf16* Wpb_t = (bf16*)(ws + WS_WPB); bf16* Wout_t = (bf16*)(ws + WS_WOUT); bf16* Wup_t = (bf16*)(ws + WS_WUP); bf16* Wdn_t = (bf16*)(ws + WS_WDN); \
    bf16* Wlora_t = (bf16*)(ws + WS_WLORA); bf16* Wlru_t = (bf16*)(ws + WS_WLRU); \
    bf16* YA = (bf16*)(ws + WS_YA); bf16* YB = (bf16*)(ws + WS_YB); \
    bf16* XN = (bf16*)(ws + WS_XN); bf16* P = (bf16*)(ws + WS_P); bf16* HALO = (bf16*)(ws + WS_HALO); bf16* LA = (bf16*)(ws + WS_LA); bf16* XC = (bf16*)(ws + WS_XC); \
    bf16* L = (bf16*)(ws + WS_L); float* LRA = (float*)(ws + WS_LRA); bf16* LRB = (bf16*)(ws + WS_LRB); \
    float* SB = (float*)(ws + WS_R); bf16* Yr = (bf16*)(ws + WS_Y); \
    bf16* T1 = (bf16*)(ws + WS_T1); bf16* MIX = (bf16*)(ws + WS_MIX); bf16* XN2 = (bf16*)(ws + WS_XN2); bf16* Z = (bf16*)(ws + WS_Z); \
    bf16* GATES = (bf16*)p.out;

#define XB_TMO      128
#define XB_XCNT(j)  (256  + 64 * (j))
#define XB_XSUB(j)  (1280 + 64 * (j))
#define XB_XGEN(j)  (2304 + 64 * (j))
#define XB_TOP      3328
#define XB_TOPGEN   3392
#define XCD_BAR_WORDS 3456
#define XB_SPIN_CAP (1u << 18)

__device__ __forceinline__ unsigned xb_ld(unsigned* p)              { return __hip_atomic_load(p, __ATOMIC_RELAXED, __HIP_MEMORY_SCOPE_AGENT); }
__device__ __forceinline__ unsigned xb_add(unsigned* p, unsigned v) { return __hip_atomic_fetch_add(p, v, __ATOMIC_RELAXED, __HIP_MEMORY_SCOPE_AGENT); }
__device__ __forceinline__ unsigned xb_xcc_id() { return (unsigned)__builtin_amdgcn_s_getreg((3 << 11) | 20) & 0xFu; }
#define XB_SPIN(cond, bar) do { unsigned _sp = 0; while (cond) { __builtin_amdgcn_s_sleep(1); \
    if ((++_sp & 255u) == 0u) { if (xb_ld(&(bar)[XB_TMO])) break; if (_sp > XB_SPIN_CAP) { atomicAdd(&(bar)[XB_TMO], 1u); break; } } } } while (0)

struct XcdBarrier {
    unsigned* bar; unsigned x;
    volatile LAS unsigned* st;
};

__device__ __forceinline__ XcdBarrier xcd_barrier_post(unsigned* bar, volatile LAS unsigned* st) {
    XcdBarrier b; b.bar = bar; b.x = xb_xcc_id(); b.st = st;
    if (threadIdx.x == 0) (void)xb_add(&bar[XB_XCNT(b.x)], 1u);
    return b;
}
__device__ __forceinline__ void xcd_barrier_complete(unsigned* bar, unsigned x, unsigned& nloc, unsigned& nx) {
    const unsigned G = gridDim.x * gridDim.y * gridDim.z;
    unsigned sum, cnt, mine, sp = 0u;
    for (;;) {
        sum = 0u; cnt = 0u; mine = 0u;
#pragma unroll
        for (unsigned j = 0; j < 16; ++j) { const unsigned c = xb_ld(&bar[XB_XCNT(j)]); sum += c; cnt += (c > 0u) ? 1u : 0u; mine = (j == x) ? c : mine; }
        if (sum == G) break;
        __builtin_amdgcn_s_sleep(1);
        if ((++sp & 255u) == 0u) { if (xb_ld(&bar[XB_TMO])) break; if (sp > XB_SPIN_CAP) { atomicAdd(&bar[XB_TMO], 1u); break; } }
    }
    nloc = mine > 0u ? mine : 1u; nx = cnt > 0u ? cnt : 1u;
}

__device__ __forceinline__ void xcd_barrier(const XcdBarrier& b) {
    asm volatile("s_waitcnt vmcnt(0)" ::: "memory");
    __syncthreads();
    if (threadIdx.x == 0) {
        unsigned* bar = b.bar;
        __builtin_amdgcn_s_waitcnt(0);
        unsigned nloc = b.st[0], nx = b.st[1];
        if (nloc == 0u) { xcd_barrier_complete(bar, b.x, nloc, nx); b.st[0] = nloc; b.st[1] = nx; }
        const unsigned old = xb_add(&bar[XB_XSUB(b.x)], 1u);
        const unsigned gen = old / nloc;
        if (old + 1u == (gen + 1u) * nloc) {
            __builtin_amdgcn_fence(__ATOMIC_RELEASE, "agent");
            asm volatile("s_waitcnt vmcnt(0)" ::: "memory");
            const unsigned og = xb_add(&bar[XB_TOP], 1u);
            const unsigned tg = og / nx;
            if (og + 1u == (tg + 1u) * nx) xb_add(&bar[XB_TOPGEN], 1u);
            else XB_SPIN(xb_ld(&bar[XB_TOPGEN]) == tg, bar);
            __builtin_amdgcn_fence(__ATOMIC_ACQUIRE, "agent");
            xb_add(&bar[XB_XGEN(b.x)], 1u);
            asm volatile("s_waitcnt vmcnt(0)" ::: "memory");
        } else {
            XB_SPIN(xb_ld(&bar[XB_XGEN(b.x)]) == gen, bar);
            __builtin_amdgcn_fence(__ATOMIC_ACQUIRE, "agent");
            asm volatile("s_waitcnt vmcnt(0)" ::: "memory");
        }
    }
    __syncthreads();
}

#define LBAR() asm volatile("s_waitcnt lgkmcnt(0)\n\ts_barrier" ::: "memory")
#ifndef PROBE
#define PROBE 0
#endif
#define REP(k) for (int rep_ = 0; rep_ < ((PROBE == (k)) ? 2 : 1); ++rep_)
__global__ void __launch_bounds__(512, 2) fwd_megakernel(Params p) {
    extern __shared__ __attribute__((aligned(16))) unsigned char lds_raw[];
    cg::grid_group grid = cg::this_grid();
    LAS unsigned char* lds = (LAS unsigned char*)lds_raw;
    const int tid = threadIdx.x, lane = tid & 63, wave = __builtin_amdgcn_readfirstlane(tid >> 6);
    const int G = gridDim.x, bid = blockIdx.x, gw = bid * 8 + wave, NGW = G * 8, NGT = G * 512;
#define gtid (bid * 512 + opaque(tid))
    constexpr int HALO_PAR = NB * 3 * PC;

    REP(14) {
        DECL_PTRS
        LAS float* scr = (LAS float*)(lds + wave * 16384);
        const int lane = opaque(tid) & 63;
        constexpr int I_IN = (D / 64) * (NCOL / 32), I_SQ = (D / 64) * (D / 32), I_UP = (D / 64) * (FF / 32), I_DN = (FF / 64) * (D / 32);
        constexpr int NITEMS = I_IN + 3 * I_SQ + I_UP + I_DN;
        for (int it = gw; it < NITEMS; it += NGW) {
            int r = it;
            if (r < I_IN) { transpose_item(p.w_in, D, NCOL, Win_t, scr, r, lane); continue; } r -= I_IN;
            if (r < I_SQ) { transpose_item(p.w_proj_a, D, D, Wpa_t, scr, r, lane); continue; } r -= I_SQ;
            if (r < I_SQ) { transpose_item(p.w_proj_b, D, D, Wpb_t, scr, r, lane); continue; } r -= I_SQ;
            if (r < I_SQ) { transpose_item(p.w_out, D, D, Wout_t, scr, r, lane); continue; } r -= I_SQ;
            if (r < I_UP) { transpose_item(p.w_ff_up, D, FF, Wup_t, scr, r, lane); continue; } r -= I_UP;
            transpose_item(p.w_ff_down, FF, D, Wdn_t, scr, r, lane);
        }
        for (int e = gtid; e < 3072 * 128; e += NGT) {
            const int n = e >> 7, k = e & 127; float v;
            if (n < 1024) v = (k < 64) ? p.w_decay_up[k * 1024 + n] : 0.f;
            else if (n < 2048) v = (k >= 64) ? p.w_aaa_up[(k - 64) * 1024 + (n - 1024)] : 0.f;
            else v = p.w_gate_up[k * 1024 + (n - 2048)];
            Wlora_t[e] = (bf16)f2bf(v);
        }
        for (int e = gtid; e < 2048 * 128; e += NGT) {
            const int n = e >> 7, k = e & 127, pj = n >> 8, nn = n & 255, blk = nn >> 7, gate = (nn >> 6) & 1, j = nn & 63, kb = k >> 6, i = k & 63;
            const float* W = gate ? p.lru_wx : p.lru_wa;
            const float v = (kb == blk) ? W[((2 * pj + blk) * 64 + i) * 64 + j] : 0.f;
            Wlru_t[e] = (bf16)f2bf(v);
        }
        for (int e = gtid; e < HALO_PAR / 2; e += NGT) ((unsigned*)HALO)[e] = 0u;
        for (int e = gtid; e < 256 * 4 * 64 * 4; e += NGT) SST[e] = 0.f;
        for (int e = gtid; e < NB * 1024; e += NGT) LST[e] = 0.f;
        for (int e = gtid; e < 1024; e += NGT) CL[e] = -8.0f * log1pf(__expf(-p.lru_lambda[e]));
        for (int m = gw; m < NB * NMETA; m += NGW) rms_row_to_bf16(p.meta + (size_t)(m & 15) * D, p.norm_mix_g, XN + (size_t)m * D, opaque(tid) & 63);
        for (int e = gtid; e < XCD_BAR_WORDS; e += NGT) __hip_atomic_store((unsigned*)(ws + WS_BAR) + e, 0u, __ATOMIC_RELAXED, __HIP_MEMORY_SCOPE_AGENT);
        if (tid < 16) ((volatile LAS unsigned*)(lds + 131072))[tid] = 0u;
    }
    grid.sync();
    const XcdBarrier xbar = xcd_barrier_post((unsigned*)(p.ws + WS_BAR), (volatile LAS unsigned*)(lds + 131072) + 8);
#define GRID_SYNC() xcd_barrier(xbar)

    for (int s = 0; s < NSEG; ++s) {
        const int lgT = (s == 0) ? 4 : LGSEG, SEGT = 1 << lgT, Mseg = NB * SEGT, Mpad = (s == 0) ? 256 : MSEGMAX, gbase = (s == 0) ? 0 : (s - 1) * SEGMAX, nch = SEGT / CH;
        REP(5) { DECL_PTRS bf16* halo_next = HALO + (size_t)((s + 1) & 1) * HALO_PAR; OpP op{P, halo_next, GATES, Mseg, lgT, gbase, s}; run_gemm<OpP, true>(lds, XN, D, Win_t, Mpad, NCOL, D, 0, 0, op); }
        GRID_SYNC();
        REP(6) { DECL_PTRS const bf16* halo_cur = HALO + (size_t)(s & 1) * HALO_PAR;
        for (int m = gw; m < Mseg; m += NGW) {
            const int lane = opaque(tid) & 63;
            const int b = m >> lgT, i = m & (SEGT - 1);
            const bf16* cur = P + (size_t)m * PC;
            const bf16* pr1 = (i >= 1) ? cur - PC : halo_cur + (size_t)(b * 3 + 2) * PC;
            const bf16* pr2 = (i >= 2) ? cur - 2 * PC : halo_cur + (size_t)(b * 3 + 1 + i) * PC;
            const bf16* pr3 = (i >= 3) ? cur - 3 * PC : halo_cur + (size_t)(b * 3 + i) * PC;
            {
                const int c = 4 * lane; const v2u cw = *(const v2u*)(cur + OFF_WD + c), pw = *(const v2u*)(pr1 + OFF_WD + c); const f32x4 mu = *(const f32x4*)(p.mu + OFF_WD + c);
                float x0 = bflo(cw.x), x1 = bfhi(cw.x), x2 = bflo(cw.y), x3 = bfhi(cw.y);
                x0 += (bflo(pw.x) - x0) * mu.x; x1 += (bfhi(pw.x) - x1) * mu.y; x2 += (bflo(pw.y) - x2) * mu.z; x3 += (bfhi(pw.y) - x3) * mu.w;
                if (lane < 16) { x0 = tanhf_(x0); x1 = tanhf_(x1); x2 = tanhf_(x2); x3 = tanhf_(x3); }
                else if (lane >= 32) { x0 = sigmoidf_(x0); x1 = sigmoidf_(x1); x2 = sigmoidf_(x2); x3 = sigmoidf_(x3); }
                v2u o; o.x = pk2(x0, x1); o.y = pk2(x2, x3); *(v2u*)(LA + (size_t)m * 256 + c) = o;
            }
            {
                const int c = 16 * lane; float x0[16], x1[16], x2[16], x3[16], w[16], o[16];
                load16bf(pr3 + OFF_XB + c, x0); load16bf(pr2 + OFF_XB + c, x1); load16bf(pr1 + OFF_XB + c, x2); load16bf(cur + OFF_XB + c, x3);
                load16f(p.conv_b + c, o);
                load16f(p.conv_w + c, w);
#pragma unroll
                for (int j = 0; j < 16; ++j) o[j] += x0[j] * w[j];
                load16f(p.conv_w + 1024 + c, w);
#pragma unroll
                for (int j = 0; j < 16; ++j) o[j] += x1[j] * w[j];
                load16f(p.conv_w + 2048 + c, w);
#pragma unroll
                for (int j = 0; j < 16; ++j) o[j] += x2[j] * w[j];
                load16f(p.conv_w + 3072 + c, w);
#pragma unroll
                for (int j = 0; j < 16; ++j) o[j] += x3[j] * w[j];
                store16bf(XC + (size_t)m * 1024 + c, o);
            }
        } }
        GRID_SYNC();
        REP(7) { DECL_PTRS OpLora op{L, Mseg}; run_gemm<OpLora, true>(lds, LA, 256, Wlora_t, Mpad, 3072, 128, 3, 128, op); }
        REP(7) { DECL_PTRS OpLru op{LRA, LRB, XC, CL, p.lru_ba, p.lru_bx, Mseg}; run_gemm<OpLru, true>(lds, XC, 1024, Wlru_t, Mpad, 2048, 128, 0, 128, op); }
        GRID_SYNC();
        REP(3) { DECL_PTRS const bf16* halo_cur = HALO + (size_t)(s & 1) * HALO_PAR;
        const int lch = (SEGT < 32) ? SEGT : 32, nlc = SEGT / lch;
        const bool lru_bg = (s >= 1) && (G == 256) && (SEGT == 2048);
        if (!lru_bg)
        for (int idx = gtid; idx < NB * nlc * 512; idx += NGT) {
            const int c = 2 * (idx & 511), q = idx >> 9, chunk = q % nlc, b = q / nlc; const size_t m0 = (size_t)b * SEGT + chunk * lch;
            f32x2 ap = {1.f, 1.f}, bacc = {0.f, 0.f};
#pragma unroll 32
            for (int j = 0; j < lch; ++j) { const f32x2 a = *(const f32x2*)(LRA + (m0 + j) * 1024 + c); const unsigned lb = *(const unsigned*)(LRB + (m0 + j) * 1024 + c);
                const f32x2 bb = {sqrtf_(fmaxf(1.0f - a.x * a.x, 0.f)) * bflo(lb), sqrtf_(fmaxf(1.0f - a.y * a.y, 0.f)) * bfhi(lb)}; bacc = a * bacc + bb; ap = ap * a; }
            *(f32x2*)(CHA + (size_t)(b * 64 + chunk) * 1024 + c) = ap; *(f32x2*)(CHBv + (size_t)(b * 64 + chunk) * 1024 + c) = bacc;
        }
        const int nch = (SEGT + CH - 1) / CH;
        for (int u = bid; u < 256; u += G) {
            const int tq = opaque(tid), lane = tq & 63;
            const int bh = (u & 7) * 8 + ((u >> 3) >> 2), rg = (u >> 3) & 3, b = bh >> 4, h = bh & 15, mrow0 = b * SEGT, hcol = h * 64, vcol = hcol + rg * 16;
            __syncthreads();
            if (wave >= 4) {
                const int pt = tq - 256, pj = pt >> 4, pq = pt & 15, pc = hcol + 4 * pq;
                const f32x4 mu_r = *(const f32x4*)(p.mu + pc), mu_k = *(const f32x4*)(p.mu + 1024 + pc), mu_v = *(const f32x4*)(p.mu + 2048 + pc), c_w0 = *(const f32x4*)(p.w0 + pc), c_a0 = *(const f32x4*)(p.a0 + pc),
                            c_kk = *(const f32x4*)(p.k_k + pc), c_ka = *(const f32x4*)(p.k_a + pc), c_rk = *(const f32x4*)(p.r_k + pc);
                const bf16* halo_b = halo_cur + (size_t)(b * 3 + 2) * PC;
#define PREP_DECL(X) v2u X##rc, X##rp, X##kc, X##kp, X##vc, X##vp, X##ld, X##la
                PREP_DECL(A0); PREP_DECL(A1); PREP_DECL(B0); PREP_DECL(B1);
#define PREP_LOAD(X, cc, toff) { const int tj_ = (cc) * CH + pj + (toff); const bf16* cur_ = P + (size_t)(mrow0 + tj_) * PC; const bf16* prv_ = (tj_ >= 1) ? cur_ - PC : halo_b; \
                X##rc = *(const v2u*)(cur_ + pc); X##rp = *(const v2u*)(prv_ + pc); X##kc = *(const v2u*)(cur_ + 1024 + pc); X##kp = *(const v2u*)(prv_ + 1024 + pc); X##vc = *(const v2u*)(cur_ + 2048 + pc); X##vp = *(const v2u*)(prv_ + 2048 + pc); \
                const bf16* l_ = L + (size_t)(mrow0 + tj_) * 3072 + pc; X##ld = *(const v2u*)l_; X##la = *(const v2u*)(l_ + 1024); }
#define SHIFT4(C, Q, MU) ((f32x4){bflo(C.x) + (bflo(Q.x) - bflo(C.x)) * MU.x, bfhi(C.x) + (bfhi(Q.x) - bfhi(C.x)) * MU.y, bflo(C.y) + (bflo(Q.y) - bflo(C.y)) * MU.z, bfhi(C.y) + (bfhi(Q.y) - bfhi(C.y)) * MU.w})
#define PREP_CW(X, cc, bufp, toff) { const int tj_ = (cc) * CH + pj + (toff); LAS unsigned char* rec_ = (bufp) + (pj + (toff)) * (REC * 4); const bool ok_ = tj_ < SEGT; \
                const f32x4 r_ = SHIFT4(X##rc, X##rp, mu_r), k_ = SHIFT4(X##kc, X##kp, mu_k), v_ = SHIFT4(X##vc, X##vp, mu_v); \
                f32x4 w_, a_; w_.x = __expf(-0.6065306597126334f * sigmoidf_(c_w0.x + bflo(X##ld.x))); w_.y = __expf(-0.6065306597126334f * sigmoidf_(c_w0.y + bfhi(X##ld.x))); w_.z = __expf(-0.6065306597126334f * sigmoidf_(c_w0.z + bflo(X##ld.y))); w_.w = __expf(-0.6065306597126334f * sigmoidf_(c_w0.w + bfhi(X##ld.y))); \
                a_.x = sigmoidf_(c_a0.x + bflo(X##la.x)); a_.y = sigmoidf_(c_a0.y + bfhi(X##la.x)); a_.z = sigmoidf_(c_a0.z + bflo(X##la.y)); a_.w = sigmoidf_(c_a0.w + bfhi(X##la.y)); \
                f32x4 q_ = k_ * c_kk; const float ss_ = red16((q_.x * q_.x + q_.y * q_.y) + (q_.z * q_.z + q_.w * q_.w)); q_ = q_ * rsqf_(fmaxf(ss_, 1e-24f)); \
                f32x4 km_ = k_ * (1.0f + (a_ - 1.0f) * c_ka), bb_ = q_ * a_; \
                const f32x4 rk_ = r_ * km_ * c_rk; const float sb_ = red16((rk_.x + rk_.y) + (rk_.z + rk_.w)); \
                if (rg == 0 && pq == 0 && ok_) SB[(size_t)(mrow0 + tj_) * 16 + h] = sb_; \
                if (!ok_) { w_ = (f32x4){1.f, 1.f, 1.f, 1.f}; km_ = (f32x4){0.f, 0.f, 0.f, 0.f}; bb_ = km_; q_ = km_; }     \
                *(LAS f32x4*)(rec_ + pq * 16) = ok_ ? r_ : (f32x4){0.f, 0.f, 0.f, 0.f}; *(LAS f32x4*)(rec_ + 256 + pq * 16) = w_; *(LAS f32x4*)(rec_ + 512 + pq * 16) = km_; *(LAS f32x4*)(rec_ + 768 + pq * 16) = q_; *(LAS f32x4*)(rec_ + 1024 + pq * 16) = bb_; \
                if ((pq >> 2) == rg) *(LAS f32x4*)(rec_ + 1280 + (pq & 3) * 16) = ok_ ? v_ : (f32x4){0.f, 0.f, 0.f, 0.f}; }
#define CLAMPC(x) (((x) < nch) ? (x) : nch - 1)
                PREP_LOAD(A0, 0, 0); PREP_LOAD(A1, 0, 16); PREP_LOAD(B0, CLAMPC(1), 0); PREP_LOAD(B1, CLAMPC(1), 16);
                PREP_CW(A0, 0, lds, 0); PREP_CW(A1, 0, lds, 16); PREP_LOAD(A0, CLAMPC(2), 0); PREP_LOAD(A1, CLAMPC(2), 16);
                const float one_ = __builtin_bit_cast(float, opaque(0x3f800000)), zero_ = __builtin_bit_cast(float, opaque(0));
                f32x2 l_ap = {one_, one_}, l_b = {zero_, zero_};
                for (int c = 0; c < nch; c += 2) {
                    LBAR();
                    if (c + 1 < nch) { PREP_CW(B0, c + 1, lds + CHBYTES, 0); PREP_CW(B1, c + 1, lds + CHBYTES, 16); PREP_LOAD(B0, CLAMPC(c + 3), 0); PREP_LOAD(B1, CLAMPC(c + 3), 16); }
                    const bool dolru = lru_bg && (u == bid) && ((c & 7) == 4);
                    const int lsel = c >> 3, lidx = bid * 512 + pt + 256 * (lsel >> 2), lhb = lsel & 3;
                    const int lc = 2 * (lidx & 511), lq = lidx >> 9, lchunk = lq & 63, lb2 = lq >> 6; const size_t lm0 = (size_t)lb2 * SEGT + lchunk * 32 + lhb * 8;
                    f32x2 la[8]; unsigned lbv[8];
                    if (dolru) {
#pragma unroll
                        for (int j = 0; j < 8; ++j) { la[j] = *(const f32x2*)(LRA + (lm0 + j) * 1024 + lc); lbv[j] = *(const unsigned*)(LRB + (lm0 + j) * 1024 + lc); }
                    } else {
#pragma unroll
                        for (int j = 0; j < 8; ++j) { la[j] = (f32x2){zero_, zero_}; lbv[j] = 0u; }
                    }
                    if (c + 1 >= nch) break;
                    LBAR();
                    if (c + 2 < nch) { PREP_CW(A0, c + 2, lds, 0); PREP_CW(A1, c + 2, lds, 16); PREP_LOAD(A0, CLAMPC(c + 4), 0); PREP_LOAD(A1, CLAMPC(c + 4), 16); }
                    if (dolru) {
                        if (lhb == 0) { l_ap = (f32x2){one_, one_}; l_b = (f32x2){zero_, zero_}; }
#pragma unroll
                        for (int j = 0; j < 8; ++j) { const f32x2 a = la[j]; const f32x2 bb = {sqrtf_(fmaxf(1.0f - a.x * a.x, 0.f)) * bflo(lbv[j]), sqrtf_(fmaxf(1.0f - a.y * a.y, 0.f)) * bfhi(lbv[j])}; l_b = a * l_b + bb; l_ap = l_ap * a; }
                        if (lhb == 3) { *(f32x2*)(CHA + (size_t)(lb2 * 64 + lchunk) * 1024 + lc) = l_ap; *(f32x2*)(CHBv + (size_t)(lb2 * 64 + lchunk) * 1024 + lc) = l_b; }
                    }
                }
#undef PREP_DECL
#undef PREP_LOAD
#undef PREP_CW
#undef SHIFT4
#undef CLAMPC
            } else {
                const int g4 = lane >> 4, kq = lane & 15;
                float* sst = SST + ((size_t)(u * 4 + wave) * 64 + lane) * 4;
                f32x2 S01, S23; { const f32x4 S = *(const f32x4*)sst; S01 = (f32x2){S.x, S.y}; S23 = (f32x2){S.z, S.w}; }
                const int ycol = vcol + wave * 4 + g4;
                const int lo = kq * 16, vo = 1280 + (wave * 4 + g4) * 4;
#define SC_DECL(X) f32x4 X##r, X##w, X##k, X##q, X##b; float X##v
#define SC_LD(X, j) { const LAS unsigned char* rec_ = buf + (j) * (REC * 4); X##r = *(const LAS f32x4*)(rec_ + lo); X##w = *(const LAS f32x4*)(rec_ + 256 + lo); X##k = *(const LAS f32x4*)(rec_ + 512 + lo); \
                      X##q = *(const LAS f32x4*)(rec_ + 768 + lo); X##b = *(const LAS f32x4*)(rec_ + 1024 + lo); X##v = *(const LAS float*)(rec_ + vo); }
#define SC_CP(X, Y) { X##r = Y##r; X##w = Y##w; X##k = Y##k; X##q = Y##q; X##b = Y##b; X##v = Y##v; }
#define LO2(v) ((f32x2){(v).x, (v).y})
#define HI2(v) ((f32x2){(v).z, (v).w})
#define SC_STEP(X, j) { f32x2 ta = S01 * LO2(X##q); ta = S23 * HI2(X##q) + ta; f32x2 tb = S01 * LO2(Pr); tb = S23 * HI2(Pr) + tb; \
                        float sa = ta.x + ta.y, yy = tb.x + tb.y; const f32x2 kv01 = LO2(X##k) * X##v, kv23 = HI2(X##k) * X##v; \
                        sa += dppf(sa, 0); yy += dppf(yy, 0); sa += dppf(sa, 1); yy += dppf(yy, 1); sa += dppf(sa, 2); yy += dppf(yy, 2); sa += dppf(sa, 3); yy += dppf(yy, 3); \
                        if ((j) > 0 && (j) <= 16) yk0 = (kq == (j) - 1) ? yy : yk0; if ((j) > 16) yk1 = (kq == (j) - 17) ? yy : yk1; \
                        S01 = S01 * LO2(X##w) + (kv01 - LO2(X##b) * sa); S23 = S23 * HI2(X##w) + (kv23 - HI2(X##b) * sa); Pr = X##r; }
                for (int c = 0; c < nch; ++c) {
                    LBAR();
                    const LAS unsigned char* buf = lds + (c & 1) * CHBYTES;
                    float yk0 = 0.f, yk1 = 0.f; f32x4 Pr;
                    SC_DECL(C0); SC_DECL(N0);
                    SC_LD(C0, 0);
                    SC_CP(N0, C0); Pr = C0r;
#pragma unroll
                    for (int j = 0; j < CH; ++j) {
                        if (j + 1 < CH) SC_LD(N0, j + 1);
                        SC_STEP(C0, j);
                        SC_CP(C0, N0);
                    }
                    { f32x2 tb = S01 * LO2(Pr); tb = S23 * HI2(Pr) + tb; const float yy = red16(tb.x + tb.y); yk1 = (kq == 15) ? yy : yk1; }
                    const int t0c = c * CH + kq;
                    if (t0c < SEGT) Yr[(size_t)(mrow0 + t0c) * 1024 + ycol] = (bf16)f2bf(yk0);
                    if (t0c + 16 < SEGT) Yr[(size_t)(mrow0 + t0c + 16) * 1024 + ycol] = (bf16)f2bf(yk1);
                }
#undef SC_DECL
#undef SC_LD
#undef SC_CP
#undef SC_STEP
#undef LO2
#undef HI2
                if (PROBE != 3 || rep_ == 1) *(f32x4*)sst = (f32x4){S01.x, S01.y, S23.x, S23.y};
            }
        } }
        GRID_SYNC();
        REP(4) { DECL_PTRS const bf16* halo_cur = HALO + (size_t)(s & 1) * HALO_PAR;
        if (s > 0) {
            for (int m = gw; m < Mseg; m += NGW) {
                const int lane = opaque(tid) & 63;
                const int b = m >> lgT, i = m & (SEGT - 1), c = 16 * lane; const size_t o = (size_t)m * 1024 + c;
                const bf16* cur = P + (size_t)m * PC; const bf16* pr1 = (i >= 1) ? cur - PC : halo_cur + (size_t)(b * 3 + 2) * PC;
                float y[16], t[16], u[16];
                load16bf(Yr + o, y); float sm = 0.f;
#pragma unroll
                for (int j = 0; j < 16; ++j) sm += y[j];
                const float mean = quad_sum(sm) * (1.f / 64.f); float vs = 0.f;
#pragma unroll
                for (int j = 0; j < 16; ++j) { y[j] -= mean; vs += y[j] * y[j]; }
                const float rstd = rsqf_(quad_sum(vs) * (1.f / 64.f) + LNX_EPS);
                load16f(p.ln_w + c, t); load16f(p.ln_b + c, u);
#pragma unroll
                for (int j = 0; j < 16; ++j) y[j] = y[j] * rstd * t[j] + u[j];
                const float bs = SB[(size_t)m * 16 + (lane >> 2)];
                shift16(cur + 2048 + c, pr1 + 2048 + c, p.mu + 2048 + c, t); load16bf(L + (size_t)m * 3072 + 2048 + c, u);
#pragma unroll
                for (int j = 0; j < 16; ++j) y[j] = (y[j] + bs * t[j]) * u[j];
                store16bf(YA + ((size_t)b * SEQ + gbase + i) * 1024 + c, y);
            }
        }
        {
            const int lch = (SEGT < 32) ? SEGT : 32, nlc = SEGT / lch;
            const float* LSTin = LST + (size_t)(s & 1) * (NB * 1024); float* LSTout = LST + (size_t)((s + 1) & 1) * (NB * 1024);
            for (int idx = gtid; idx < NB * nlc * 512; idx += NGT) {
                const int c = 2 * (idx & 511), q = idx >> 9, chunk = q % nlc, b = q / nlc; const size_t m0 = (size_t)b * SEGT + chunk * lch;
                f32x2 hh = *(const f32x2*)(LSTin + b * 1024 + c);
#pragma unroll 16
                for (int k = 0; k < chunk; ++k) { const size_t o = (size_t)(b * 64 + k) * 1024 + c; hh = *(const f32x2*)(CHA + o) * hh + *(const f32x2*)(CHBv + o); }
#pragma unroll 32
                for (int j = 0; j < lch; ++j) {
                    const f32x2 a = *(const f32x2*)(LRA + (m0 + j) * 1024 + c); const unsigned lb = *(const unsigned*)(LRB + (m0 + j) * 1024 + c);
                    const f32x2 bb = {sqrtf_(fmaxf(1.0f - a.x * a.x, 0.f)) * bflo(lb), sqrtf_(fmaxf(1.0f - a.y * a.y, 0.f)) * bfhi(lb)}; hh = a * hh + bb;
                    if (s > 0) { const unsigned yb = *(const unsigned*)(P + (m0 + j) * PC + OFF_YB + c);
                        *(unsigned*)(YB + ((size_t)b * SEQ + gbase + chunk * lch + j) * 1024 + c) = pk2(hh.x * gelu_tanh(bflo(yb)), hh.y * gelu_tanh(bfhi(yb))); }
                }
                if (chunk == nlc - 1 && (PROBE != 4 || rep_ == 1)) *(f32x2*)(LSTout + b * 1024 + c) = hh;
            }
        }
        if (s + 1 < NSEG) {
            for (int m = gw; m < MSEGMAX; m += 4 * NGW) {
                int mr[4]; const float* xr[4]; bf16* orow[4];
#pragma unroll
                for (int r = 0; r < 4; ++r) { mr[r] = (m + r * NGW < MSEGMAX) ? m + r * NGW : m; const int b = mr[r] >> LGSEG, i = mr[r] & (SEGMAX - 1); xr[r] = p.x + ((size_t)b * SEQ + (size_t)s * SEGMAX + i) * D; orow[r] = XN + (size_t)mr[r] * D; }
                rms_rows4_to_bf16(xr[0], xr[1], xr[2], xr[3], p.norm_mix_g, orow[0], orow[1], orow[2], orow[3], opaque(tid) & 63);
            }
        } }
        GRID_SYNC();
    }

    REP(10) { DECL_PTRS OpT1 op{T1, GATES}; run_gemm<OpT1, true>(lds, YA, D, Wpa_t, MT, D, D, 0, 0, op); }
    REP(10) { DECL_PTRS OpMix op{T1, GATES, MIX}; run_gemm<OpMix, true>(lds, YB, D, Wpb_t, MT, D, D, 0, 0, op); }
    { DECL_PTRS const int st_ = opaque(NGT); for (int e = gtid; e < MT; e += st_) CAR[e] = 0.f; }
    GRID_SYNC();
    REP(11) { DECL_PTRS OpH1 op{p.x, p.out, p.norm_ffn_g, XN2, CAR}; run_gemm<OpH1, true>(lds, MIX, D, Wout_t, MT, D, D, 0, 0, op); }
    GRID_SYNC();
    REP(13) { DECL_PTRS OpZ op{Z, CAR}; run_gemm<OpZ, true>(lds, XN2, D, Wup_t, MT, FF, D, 0, 0, op); }
    GRID_SYNC();
    { DECL_PTRS OpAcc op{p.out}; run_gemm<OpAcc, true>(lds, Z, FF, Wdn_t, MT, D, FF, 0, 0, op); }
    GRID_SYNC();
    for (int m = gw; m < MT; m += 4 * NGW) {
        const int lane = opaque(tid) & 63;
        float* rows[4]; f32x4 v[4][4];
#pragma unroll
        for (int r = 0; r < 4; ++r) { const int mr = (m + r * NGW < MT) ? m + r * NGW : m; rows[r] = p.out + (size_t)mr * D;
#pragma unroll
            for (int j = 0; j < 4; ++j) v[r][j] = *((const f32x4*)rows[r] + lane + 64 * j); }
        f32x4 gg[4];
#pragma unroll
        for (int j = 0; j < 4; ++j) gg[j] = *((const f32x4*)p.norm_final_g + lane + 64 * j);
#pragma unroll
        for (int r = 0; r < 4; ++r) {
            float sq = 0.f;
#pragma unroll
            for (int j = 0; j < 4; ++j) sq += (v[r][j].x * v[r][j].x + v[r][j].y * v[r][j].y) + (v[r][j].z * v[r][j].z + v[r][j].w * v[r][j].w);
            const float sc = rsqf_(wave_sum(sq) * (1.f / D) + RMS_EPS);
            if (r == 0 || m + r * NGW < MT) {
#pragma unroll
                for (int j = 0; j < 4; ++j) *((f32x4*)rows[r] + lane + 64 * j) = v[r][j] * sc * gg[j];
            }
        }
    }
    if (PROBE == 1) { for (int i = 0; i < 40; ++i) GRID_SYNC(); }
}

extern "C" void kernel_launch(void* const* d_in, const int* in_sizes, int n_in, void* d_out, int out_size, void* d_ws, size_t ws_size, hipStream_t stream) {
    static int grid_blocks = 0;
    if (grid_blocks == 0) {
        if (n_in != 29 || ws_size < WS_TAIL_END) { fprintf(stderr, "kernel_launch: unexpected n_in %d or ws_size %zu (< %zu)\n", n_in, ws_size, (size_t)WS_END); grid_blocks = -1; return; }
        int dev = 0, cus = 0, per_cu = 0;
        hipGetDevice(&dev);
        hipDeviceGetAttribute(&cus, hipDeviceAttributeMultiprocessorCount, dev);
        hipFuncSetAttribute((const void*)fwd_megakernel, hipFuncAttributeMaxDynamicSharedMemorySize, LDS_BYTES);
        hipOccupancyMaxActiveBlocksPerMultiprocessor(&per_cu, (const void*)fwd_megakernel, 512, LDS_BYTES);
        if (per_cu < 1) per_cu = 1;
        grid_blocks = cus * per_cu;
        (void)hipGetLastError();
    }
    if (grid_blocks < 0) return;
    Params p{};
    const float** f = (const float**)&p;
    for (int i = 0; i < 29; ++i) f[i] = (const float*)d_in[i];
    p.out = (float*)d_out; p.ws = (unsigned char*)d_ws;
    void* args[] = {&p};
    hipError_t e = hipLaunchCooperativeKernel((const void*)fwd_megakernel, dim3(grid_blocks), dim3(512), args, LDS_BYTES, stream);
    if (e != hipSuccess) fprintf(stderr, "cooperative launch failed: %s (grid %d)\n", hipGetErrorString(e), grid_blocks);
}
```

```cpp
#include <hip/hip_runtime.h>
#include <hip/hip_cooperative_groups.h>
#include <cstdio>
#include <cstdint>
namespace cg = cooperative_groups;

#define GAS __attribute__((address_space(1)))
#define LAS __attribute__((address_space(3)))
typedef unsigned short bf16;
typedef unsigned v4u __attribute__((ext_vector_type(4)));
typedef unsigned v2u __attribute__((ext_vector_type(2)));
typedef float f32x4 __attribute__((ext_vector_type(4)));
typedef float f32x2 __attribute__((ext_vector_type(2)));
typedef short bf16x8 __attribute__((ext_vector_type(8)));

namespace pg8 {
constexpr int BM = 256, BK = 64, HALF = 128, HTB = HALF * BK * 2, STAGE_BYTES = 8 * HTB, NXCD = 8, WGM = 8;
__host__ __device__ __forceinline__ int lds_byte(int r, int c) { const int st = (r >> 4) * 2 + (c >> 5), rr = r & 15, cc = c & 31, ob = rr * 64 + cc * 2; return st * 1024 + (ob ^ (((ob >> 9) & 1) << 5)); }
__host__ __device__ __forceinline__ void stage_rc(int b, int& R, int& C) { const int st = b / 1024, sb = b % 1024, swz = sb ^ (((sb >> 9) & 1) << 5); R = (st >> 1) * 16 + swz / 64; C = (st & 1) * 32 + (swz % 64) / 2; }
__host__ __device__ __forceinline__ int perm32(int rho) { const int n = rho >> 4, i = rho & 15; return 8 * (i >> 2) + 4 * n + (i & 3); }
struct Unit { int pm, pn; };
struct Gemm { const bf16* A; const bf16* Bt; int M, N, K, lda, ash, amul; };
struct StaticOrder {
    int nM, nN, nwg, G, c;
    __host__ __device__ void init(int M, int N, int G_, int c_) { nM = M / BM; nN = N / BM; nwg = nM * nN; G = G_; c = c_; }
    __host__ __device__ bool next(int i, Unit& u) const {
        const long L = (long)i * G + c; if (L >= nwg) return false;
        int wgid = (int)L; { const int q = nwg / NXCD, r = nwg % NXCD, xcd = wgid % NXCD, off = wgid / NXCD; wgid = (xcd < r ? xcd * (q + 1) : r * (q + 1) + (xcd - r) * q) + off; }
        const int nig = WGM * nN, gid = wgid / nig, fm = gid * WGM, gsz = (nM - fm) < WGM ? (nM - fm) : WGM;
        u.pm = fm + ((wgid % nig) % gsz); u.pn = (wgid % nig) / gsz; return true;
    }
};
template <class Op> struct EpiOp {
    static constexpr bool PERM = true;
    Op op;
    __device__ __forceinline__ void operator()(const f32x4 (&acc)[2][2][4][2], const Unit& u, int wr, int wc, int fr, int fq) const {
        int row0 = u.pm * BM + wr * 64 + fr, col0 = u.pn * BM + wc * 32 + 8 * fq;
        asm volatile("" : "+v"(row0), "+v"(col0));
#pragma unroll
        for (int ai = 0; ai < 2; ++ai)
#pragma unroll
            for (int m = 0; m < 4; ++m)
                { op(row0 + ai * HALF + m * 16, col0, acc[ai][0][m][0], acc[ai][0][m][1]); op(row0 + ai * HALF + m * 16, col0 + HALF, acc[ai][1][m][0], acc[ai][1][m][1]); asm volatile("" ::: "memory"); }
    }
};

template <class Epi, class Sched, bool ALIGN_EPI>
__device__ __forceinline__ void gemm_phase(LAS unsigned char* lds, const Gemm g, const Sched& S, const Epi& E) {
    int tid = threadIdx.x; asm volatile("" : "+v"(tid));
    const int wid = __builtin_amdgcn_readfirstlane(tid >> 6), lane = tid & 63, wr = wid >> 2, wc = wid & 3, fr = lane & 15, fq = lane >> 4;
    const int K = g.K, nt = K / BK;
    unsigned voffA[2], voffB[2];
#pragma unroll
    for (int i = 0; i < 2; ++i) { int R, C; stage_rc(tid * 16 + i * 8192, R, C); const int Rb = Epi::PERM ? ((R & ~31) + perm32(R & 31)) : R;
        voffA[i] = (unsigned)(R * g.lda + C) * 2u; voffB[i] = (unsigned)(Rb * K + C) * 2u; }
    const size_t kstep = (size_t)(BK * 2);
    const size_t hstepA = (size_t)HALF * g.lda * 2, hstepB = (size_t)HALF * K * 2;
    const size_t tstepA = 2 * hstepA, tstepB = 2 * hstepB;
    const unsigned ldsw = (unsigned)wid * 1024u;
    const int aoff = lds_byte(wr * 64 + fr, fq * 8), boff = lds_byte(wc * 32 + fr, fq * 8);
#define PG8_SA(b, h) (((b) * 2 + (h)) * HTB)
#define PG8_SB(b, h) ((4 + (b) * 2 + (h)) * HTB)
#define PG8_STAGE(bufoff, gbase, voff) do { _Pragma("unroll") for (int _i = 0; _i < 2; ++_i) \
        __builtin_amdgcn_global_load_lds((const unsigned*)((const char*)(gbase) + (voff)[_i]), (LAS unsigned*)(lds + (bufoff) + ldsw + _i * 8192), 16, 0, 0); } while (0)
#define PG8_LDA(dst, b, h) do { _Pragma("unroll") for (int m = 0; m < 4; ++m) _Pragma("unroll") for (int k = 0; k < 2; ++k) dst[m][k] = *(const LAS bf16x8*)(lds + PG8_SA(b, h) + aoff + m * 2048 + k * 1024); } while (0)
#define PG8_LDB(dst, b, h) do { _Pragma("unroll") for (int n = 0; n < 2; ++n) _Pragma("unroll") for (int k = 0; k < 2; ++k) dst[n][k] = *(const LAS bf16x8*)(lds + PG8_SB(b, h) + boff + n * 2048 + k * 1024); } while (0)
#define PG8_MMA(ai, bj, At, Bt) do { __builtin_amdgcn_s_setprio(1); _Pragma("unroll") for (int m = 0; m < 4; ++m) _Pragma("unroll") for (int n = 0; n < 2; ++n) _Pragma("unroll") for (int k = 0; k < 2; ++k) \
        acc[ai][bj][m][n] = __builtin_amdgcn_mfma_f32_16x16x32_bf16(Bt[n][k], At[m][k], acc[ai][bj][m][n], 0, 0, 0); __builtin_amdgcn_s_setprio(0); } while (0)
#define PG8_WAIT_V(n) asm volatile("s_waitcnt vmcnt(" #n ")" ::: "memory")
#define PG8_WAIT_L(n) asm volatile("s_waitcnt lgkmcnt(" #n ")" ::: "memory")
#define PG8_BAR __builtin_amdgcn_s_barrier()
#define PG8_SCHED __builtin_amdgcn_sched_barrier(0)
#define PG8_UA(u) ((const char*)g.A + (size_t)(u).pm * tstepA + (size_t)(((u).pn >> g.ash) * g.amul) * 2)
#define PG8_UB(u) ((const char*)g.Bt + (size_t)(u).pn * tstepB)
    Unit cur, nxt; int ui = 0;
    if (!S.next(0, cur)) return;
    f32x4 acc[2][2][4][2];
#pragma unroll
    for (int a = 0; a < 2; ++a)
#pragma unroll
        for (int b = 0; b < 2; ++b)
#pragma unroll
            for (int m = 0; m < 4; ++m)
#pragma unroll
                for (int n = 0; n < 2; ++n) acc[a][b][m][n] = (f32x4){0.f, 0.f, 0.f, 0.f};
    bf16x8 At[4][2], B0[2][2], B1[2][2];
    const char* cA = PG8_UA(cur); const char* cB = PG8_UB(cur);
    PG8_STAGE(PG8_SB(0, 0), cB, voffB); PG8_STAGE(PG8_SB(0, 1), cB + hstepB, voffB); PG8_STAGE(PG8_SA(0, 0), cA, voffA); PG8_STAGE(PG8_SA(0, 1), cA + hstepA, voffA);
    if (wr == 1) PG8_BAR;
    PG8_WAIT_V(2); PG8_BAR;
    PG8_STAGE(PG8_SB(1, 0), cB + kstep, voffB); PG8_STAGE(PG8_SA(1, 0), cA + kstep, voffA); PG8_STAGE(PG8_SB(1, 1), cB + hstepB + kstep, voffB);
    PG8_WAIT_V(6); PG8_BAR;
    for (;;) {
        const bool has_next = S.next(ui + 1, nxt);
        const char* nA = has_next ? PG8_UA(nxt) : cA; const char* nB = has_next ? PG8_UB(nxt) : cB;
        for (int t = 0; t < nt; t += 2) {
            const bool last = (t == nt - 2);
            const char* a1 = cA + (size_t)(t + 1) * kstep;
            const char* a2 = last ? nA : cA + (size_t)(t + 2) * kstep; const char* b2 = last ? nB : cB + (size_t)(t + 2) * kstep;
            const char* a3 = a2 + kstep; const char* b3 = b2 + kstep;
            PG8_LDB(B0, 0, 0); PG8_LDB(B1, 0, 1); PG8_SCHED; PG8_LDA(At, 0, 0); PG8_STAGE(PG8_SA(1, 1), a1 + hstepA, voffA);
            PG8_WAIT_V(8); PG8_WAIT_L(0); PG8_BAR; PG8_MMA(0, 0, At, B0); PG8_MMA(0, 1, At, B1); PG8_BAR; PG8_SCHED;
            PG8_LDA(At, 0, 1); PG8_STAGE(PG8_SB(0, 0), b2, voffB); PG8_STAGE(PG8_SB(0, 1), b2 + hstepB, voffB); PG8_STAGE(PG8_SA(0, 0), a2, voffA);
            PG8_WAIT_V(8); PG8_WAIT_L(0); PG8_BAR; PG8_MMA(1, 0, At, B0); PG8_MMA(1, 1, At, B1); PG8_BAR; PG8_SCHED;
            PG8_LDB(B0, 1, 0); PG8_LDB(B1, 1, 1); PG8_SCHED; PG8_LDA(At, 1, 0); PG8_STAGE(PG8_SA(0, 1), a2 + hstepA, voffA);
            PG8_WAIT_V(8); PG8_WAIT_L(0); PG8_BAR; PG8_MMA(0, 0, At, B0); PG8_MMA(0, 1, At, B1); PG8_BAR; PG8_SCHED;
            PG8_LDA(At, 1, 1); PG8_STAGE(PG8_SB(1, 0), b3, voffB); PG8_STAGE(PG8_SB(1, 1), b3 + hstepB, voffB); PG8_STAGE(PG8_SA(1, 0), a3, voffA);
            PG8_WAIT_V(8); PG8_WAIT_L(0); PG8_BAR; PG8_MMA(1, 0, At, B0); PG8_MMA(1, 1, At, B1); PG8_BAR; PG8_SCHED;
        }
        if constexpr (ALIGN_EPI) { if (wr == 0) PG8_BAR; }
        E(acc, cur, wr, wc, fr, fq);
        if (!has_next) break;
#pragma unroll
        for (int a = 0; a < 2; ++a)
#pragma unroll
            for (int b = 0; b < 2; ++b)
#pragma unroll
                for (int m = 0; m < 4; ++m)
#pragma unroll
                    for (int n = 0; n < 2; ++n) acc[a][b][m][n] = (f32x4){0.f, 0.f, 0.f, 0.f};
        cur = nxt; cA = nA; cB = nB; ++ui;
        if constexpr (ALIGN_EPI) { if (wr == 1) PG8_BAR; }
    }
    PG8_WAIT_V(0);
    if constexpr (!ALIGN_EPI) { if (wr == 0) PG8_BAR; }
    PG8_BAR;
#undef PG8_SA
#undef PG8_SB
#undef PG8_STAGE
#undef PG8_LDA
#undef PG8_LDB
#undef PG8_MMA
#undef PG8_WAIT_V
#undef PG8_WAIT_L
#undef PG8_BAR
#undef PG8_SCHED
#undef PG8_UA
#undef PG8_UB
}
}

constexpr int NB = 4, TT = 8208, NMETA = 16, SEQ = 8192, D = 1024, NCOL = 7424, PC = 5376, FF = 4096, NH = 16;
constexpr int MT = NB * SEQ;
constexpr int LGSEG = 11, SEGMAX = 1 << LGSEG, MSEGMAX = NB * SEGMAX;
constexpr int NSEG = 1 + SEQ / SEGMAX;
constexpr int OFF_WD = 3072, OFF_XB = 3328, OFF_YB = 4352;
constexpr float RMS_EPS = 1e-6f, LNX_EPS = 64e-5f;

constexpr size_t MiB = 1u << 20;
constexpr size_t WS_BAR = 4 * MiB + 131072;
constexpr size_t WS_SST = 0 * MiB, WS_CHA = 1 * MiB, WS_CHB = 2 * MiB, WS_CAR = 3 * MiB, WS_LST = 4 * MiB, WS_CL = 4 * MiB + 65536;
constexpr size_t WS_WIN = 5 * MiB, WS_WPA = 20 * MiB, WS_WPB = 22 * MiB, WS_WOUT = 24 * MiB, WS_WUP = 26 * MiB, WS_WDN = 34 * MiB, WS_WLORA = 42 * MiB, WS_WLRU = 43 * MiB;
constexpr size_t WS_YA = 44 * MiB, WS_YB = 108 * MiB;
constexpr size_t WS_XN = 172 * MiB, WS_P = 188 * MiB, WS_HALO = 272 * MiB, WS_LA = 273 * MiB, WS_XC = 277 * MiB, WS_L = 293 * MiB, WS_LRA = 341 * MiB, WS_LRB = 373 * MiB;
constexpr size_t WS_R = 389 * MiB  , WS_Y = 390 * MiB, WS_END = 422 * MiB;
static_assert(WS_XN + (size_t)MSEGMAX * D * 2 <= WS_P && WS_P + (size_t)MSEGMAX * PC * 2 <= WS_HALO && WS_LA + (size_t)MSEGMAX * 256 * 2 <= WS_XC && WS_XC + (size_t)MSEGMAX * 1024 * 2 <= WS_L && WS_L + (size_t)MSEGMAX * 3072 * 2 <= WS_LRA && WS_LRA + (size_t)MSEGMAX * 1024 * 4 <= WS_LRB && WS_LRB + (size_t)MSEGMAX * 1024 * 2 <= WS_R && WS_Y + (size_t)MSEGMAX * 1024 * 4 <= WS_END, "segment buffers");
constexpr size_t WS_T1 = 172 * MiB, WS_MIX = 300 * MiB, WS_XN2 = 364 * MiB, WS_Z = 44 * MiB, WS_TAIL_END = 428 * MiB;
constexpr int LDS_BYTES = 135168;

struct Params {
    const float *x, *meta, *norm_mix_g, *w_in, *mu, *w0, *w_decay_up, *a0, *w_aaa_up, *w_gate_up, *k_k, *k_a, *r_k, *ln_w, *ln_b, *w_proj_a, *conv_w, *conv_b,
        *lru_wa, *lru_ba, *lru_wx, *lru_bx, *lru_lambda, *w_proj_b, *w_out, *norm_ffn_g, *w_ff_up, *w_ff_down, *norm_final_g;
    float* out; unsigned char* ws;
};

__device__ __forceinline__ int opaque(int x) { asm volatile("" : "+v"(x)); return x; }
__device__ __forceinline__ unsigned f2bf(float f) { unsigned u = __builtin_bit_cast(unsigned, f); return (u + 0x7fffu + ((u >> 16) & 1u)) >> 16; }
__device__ __forceinline__ unsigned pk2(float lo, float hi) { unsigned r; asm("v_cvt_pk_bf16_f32 %0, %1, %2" : "=v"(r) : "v"(lo), "v"(hi)); return r; }
__device__ __forceinline__ float bflo(unsigned w) { return __builtin_bit_cast(float, w << 16); }
__device__ __forceinline__ float bfhi(unsigned w) { return __builtin_bit_cast(float, w & 0xffff0000u); }
__device__ __forceinline__ float bf1(bf16 h) { return __builtin_bit_cast(float, (unsigned)h << 16); }
__device__ __forceinline__ float rcpf_(float x) { return __builtin_amdgcn_rcpf(x); }
__device__ __forceinline__ float rsqf_(float x) { return __builtin_amdgcn_rsqf(x); }
__device__ __forceinline__ float sqrtf_(float x) { return __builtin_amdgcn_sqrtf(x); }
__device__ __forceinline__ float sigmoidf_(float x) { return rcpf_(1.0f + __expf(-x)); }
__device__ __forceinline__ float tanhf_(float x) { return 1.0f - 2.0f * rcpf_(__expf(2.0f * x) + 1.0f); }
__device__ __forceinline__ float gelu_tanh(float x) { return 0.5f * x * (1.0f + tanhf_(0.7978845608028654f * (x + 0.044715f * x * x * x))); }
__device__ __forceinline__ v4u pack8(f32x4 a, f32x4 b) { v4u w; w.x = pk2(a.x, a.y); w.y = pk2(a.z, a.w); w.z = pk2(b.x, b.y); w.w = pk2(b.z, b.w); return w; }
__device__ __forceinline__ void unpack8(v4u w, float* o) { o[0] = bflo(w.x); o[1] = bfhi(w.x); o[2] = bflo(w.y); o[3] = bfhi(w.y); o[4] = bflo(w.z); o[5] = bfhi(w.z); o[6] = bflo(w.w); o[7] = bfhi(w.w); }
template <int CTRL> __device__ __forceinline__ float dppx(float v) { return __builtin_bit_cast(float, __builtin_amdgcn_update_dpp(0, __builtin_bit_cast(int, v), CTRL, 0xf, 0xf, true)); }
__device__ __forceinline__ float wave_sum(float v) {
    v += dppx<0xB1>(v); v += dppx<0x4E>(v); v += dppx<0x141>(v); v += dppx<0x140>(v);
    v += __shfl_xor(v, 16); v += __shfl_xor(v, 32);
    return v;
}
__device__ __forceinline__ float quad_sum(float v) { v += dppx<0xB1>(v); v += dppx<0x4E>(v); return v; }
__device__ __forceinline__ void load16bf(const bf16* p, float* o) { const v4u a = *(const v4u*)p, b = *(const v4u*)(p + 8); unpack8(a, o); unpack8(b, o + 8); }
__device__ __forceinline__ void load16f(const float* p, float* o) {
#pragma unroll
    for (int j = 0; j < 4; ++j) { const f32x4 v = *(const f32x4*)(p + 4 * j); o[4 * j] = v.x; o[4 * j + 1] = v.y; o[4 * j + 2] = v.z; o[4 * j + 3] = v.w; }
}
__device__ __forceinline__ void store16f(float* p, const float* o) {
#pragma unroll
    for (int j = 0; j < 4; ++j) *(f32x4*)(p + 4 * j) = (f32x4){o[4 * j], o[4 * j + 1], o[4 * j + 2], o[4 * j + 3]};
}
__device__ __forceinline__ void store16bf(bf16* p, const float* o) {
    v4u a, b; a.x = pk2(o[0], o[1]); a.y = pk2(o[2], o[3]); a.z = pk2(o[4], o[5]); a.w = pk2(o[6], o[7]); b.x = pk2(o[8], o[9]); b.y = pk2(o[10], o[11]); b.z = pk2(o[12], o[13]); b.w = pk2(o[14], o[15]);
    *(v4u*)p = a; *(v4u*)(p + 8) = b;
}
__device__ __forceinline__ void shift16(const bf16* cur, const bf16* prev, const float* mu, float* o) {
    float c[16], q[16], m[16]; load16bf(cur, c); load16bf(prev, q); load16f(mu, m);
#pragma unroll
    for (int j = 0; j < 16; ++j) o[j] = c[j] + (q[j] - c[j]) * m[j];
}

__device__ __forceinline__ void transpose_item(const float* W, int K, int N, bf16* WT, LAS float* scr, int item, int lane) {
    const int nblk = N / 32, kb = item / nblk, nb = item % nblk, k0 = 64 * kb, n0 = 32 * nb;
    float wv[32];
#pragma unroll
    for (int i = 0; i < 32; ++i) wv[i] = W[(size_t)(k0 + 2 * i + (lane >> 5)) * N + n0 + (lane & 31)];
#pragma unroll
    for (int i = 0; i < 32; ++i) scr[(2 * i + (lane >> 5)) * 33 + (lane & 31)] = wv[i];
    asm volatile("s_waitcnt lgkmcnt(0)" ::: "memory");
    const int c = lane & 7;
#pragma unroll
    for (int j = 0; j < 4; ++j) { const int n = (lane >> 3) + 8 * j; const LAS float* s = scr + (8 * c) * 33 + n;
        v4u o; o.x = pk2(s[0 * 33], s[1 * 33]); o.y = pk2(s[2 * 33], s[3 * 33]); o.z = pk2(s[4 * 33], s[5 * 33]); o.w = pk2(s[6 * 33], s[7 * 33]);
        *(v4u*)(WT + (size_t)(n0 + n) * K + k0 + 8 * c) = o; }
    asm volatile("s_waitcnt lgkmcnt(0)" ::: "memory");
}
__device__ __forceinline__ void rms_row_to_bf16(const float* xrow, const float* g, bf16* orow, int lane) {
    f32x4 v[4]; float s = 0.f;
#pragma unroll
    for (int j = 0; j < 4; ++j) { v[j] = *((const f32x4*)xrow + lane + 64 * j); s += (v[j].x * v[j].x + v[j].y * v[j].y) + (v[j].z * v[j].z + v[j].w * v[j].w); }
    const float sc = rsqf_(wave_sum(s) * (1.f / D) + RMS_EPS);
#pragma unroll
    for (int j = 0; j < 4; ++j) { const f32x4 gg = *((const f32x4*)g + lane + 64 * j); v2u o; o.x = pk2(v[j].x * sc * gg.x, v[j].y * sc * gg.y); o.y = pk2(v[j].z * sc * gg.z, v[j].w * sc * gg.w);
        *((v2u*)orow + lane + 64 * j) = o; }
}

__device__ __forceinline__ void rms_rows4_to_bf16(const float* x0, const float* x1, const float* x2, const float* x3, const float* g, bf16* o0, bf16* o1, bf16* o2, bf16* o3, int lane) {
    const float* xs[4] = {x0, x1, x2, x3}; bf16* os[4] = {o0, o1, o2, o3};
    f32x4 v[4][4];
#pragma unroll
    for (int r = 0; r < 4; ++r)
#pragma unroll
        for (int j = 0; j < 4; ++j) v[r][j] = *((const f32x4*)xs[r] + lane + 64 * j);
    f32x4 gg[4];
#pragma unroll
    for (int j = 0; j < 4; ++j) gg[j] = *((const f32x4*)g + lane + 64 * j);
#pragma unroll
    for (int r = 0; r < 4; ++r) {
        float s = 0.f;
#pragma unroll
        for (int j = 0; j < 4; ++j) s += (v[r][j].x * v[r][j].x + v[r][j].y * v[r][j].y) + (v[r][j].z * v[r][j].z + v[r][j].w * v[r][j].w);
        const float sc = rsqf_(wave_sum(s) * (1.f / D) + RMS_EPS);
#pragma unroll
        for (int j = 0; j < 4; ++j) { v2u o; o.x = pk2(v[r][j].x * sc * gg[j].x, v[r][j].y * sc * gg[j].y); o.y = pk2(v[r][j].z * sc * gg[j].z, v[r][j].w * sc * gg[j].w); *((v2u*)os[r] + lane + 64 * j) = o; }
    }
}

struct OpP {
    bf16* P; bf16* halo_next; bf16* gates; int Mseg, lgT, gbase, s;
    __device__ __forceinline__ void operator()(int row, int col, f32x4 v0, f32x4 v1) const {
        if (row >= Mseg) return;
        const v4u w = pack8(v0, v1); const int b = row >> lgT, SEGT = 1 << lgT, i = row & (SEGT - 1);
        if (col < PC) {
            *(v4u*)(P + (size_t)row * PC + col) = w;
            if (i >= SEGT - 3) *(v4u*)(halo_next + (size_t)(b * 3 + (i - (SEGT - 3))) * PC + col) = w;
        } else if (s > 0) {
            *(v4u*)(gates + ((size_t)b * SEQ + gbase + i) * 2048 + (col - PC)) = w;
        }
    }
};
struct OpLora {
    bf16* L; int Mseg;
    __device__ __forceinline__ void operator()(int row, int col, f32x4 v0, f32x4 v1) const {
        if (row >= Mseg) return;
        *(v4u*)(L + (size_t)row * 3072 + col) = pack8(v0, v1);
    }
};
struct OpLru {
    bf16* LRA; bf16* LRB; const bf16* XC; const float* CL; const float* ba; const float* bx; int Mseg;
    __device__ __forceinline__ void operator()(int row, int col, f32x4 v0, f32x4 v1) const {
        if (row >= Mseg) return;
        float v[8] = {v0.x, v0.y, v0.z, v0.w, v1.x, v1.y, v1.z, v1.w};
        const int pj = col >> 8, nn = col & 255, blk = nn >> 7, gate = (nn >> 6) & 1, j = nn & 63, ch = 64 * (2 * pj + blk) + j;
        if (gate == 0) {
            float cl[8], bb[8]; { const f32x4 c0 = *(const f32x4*)(CL + ch), c1 = *(const f32x4*)(CL + ch + 4), b0 = *(const f32x4*)(ba + ch), b1 = *(const f32x4*)(ba + ch + 4);
                cl[0] = c0.x; cl[1] = c0.y; cl[2] = c0.z; cl[3] = c0.w; cl[4] = c1.x; cl[5] = c1.y; cl[6] = c1.z; cl[7] = c1.w; bb[0] = b0.x; bb[1] = b0.y; bb[2] = b0.z; bb[3] = b0.w; bb[4] = b1.x; bb[5] = b1.y; bb[6] = b1.z; bb[7] = b1.w; }
#pragma unroll
            for (int e = 0; e < 8; ++e) v[e] = cl[e] * sigmoidf_(v[e] + bb[e]);
            *(v4u*)(LRA + (size_t)row * 1024 + ch) = pack8((f32x4){v[0], v[1], v[2], v[3]}, (f32x4){v[4], v[5], v[6], v[7]});
        } else {
            float xc[8]; unpack8(*(const v4u*)(XC + (size_t)row * 1024 + ch), xc);
            float bb[8]; { const f32x4 b0 = *(const f32x4*)(bx + ch), b1 = *(const f32x4*)(bx + ch + 4); bb[0] = b0.x; bb[1] = b0.y; bb[2] = b0.z; bb[3] = b0.w; bb[4] = b1.x; bb[5] = b1.y; bb[6] = b1.z; bb[7] = b1.w; }
#pragma unroll
            for (int e = 0; e < 8; ++e) v[e] = sigmoidf_(v[e] + bb[e]) * xc[e];
            *(v4u*)(LRB + (size_t)row * 1024 + ch) = pack8((f32x4){v[0], v[1], v[2], v[3]}, (f32x4){v[4], v[5], v[6], v[7]});
        }
    }
};
struct OpT1 {
    bf16* T1; const bf16* gates;
    __device__ __forceinline__ void operator()(int row, int col, f32x4 v0, f32x4 v1) const {
        float gt[8]; unpack8(*(const v4u*)(gates + (size_t)row * 2048 + col), gt);
        const f32x4 a = {sigmoidf_(gt[0]) * v0.x, sigmoidf_(gt[1]) * v0.y, sigmoidf_(gt[2]) * v0.z, sigmoidf_(gt[3]) * v0.w};
        const f32x4 b = {sigmoidf_(gt[4]) * v1.x, sigmoidf_(gt[5]) * v1.y, sigmoidf_(gt[6]) * v1.z, sigmoidf_(gt[7]) * v1.w};
        *(v4u*)(T1 + (size_t)row * 1024 + col) = pack8(a, b);
    }
};
struct OpMix {
    const bf16* T1; const bf16* gates; bf16* MIX;
    __device__ __forceinline__ void operator()(int row, int col, f32x4 v0, f32x4 v1) const {
        float gt[8], t[8]; unpack8(*(const v4u*)(gates + (size_t)row * 2048 + 1024 + col), gt); unpack8(*(const v4u*)(T1 + (size_t)row * 1024 + col), t);
        const f32x4 a = {t[0] + sigmoidf_(gt[0]) * v0.x, t[1] + sigmoidf_(gt[1]) * v0.y, t[2] + sigmoidf_(gt[2]) * v0.z, t[3] + sigmoidf_(gt[3]) * v0.w};
        const f32x4 b = {t[4] + sigmoidf_(gt[4]) * v1.x, t[5] + sigmoidf_(gt[5]) * v1.y, t[6] + sigmoidf_(gt[6]) * v1.z, t[7] + sigmoidf_(gt[7]) * v1.w};
        *(v4u*)(MIX + (size_t)row * 1024 + col) = pack8(a, b);
    }
};
struct OpH1 {
    const float* x; float* out; const float* gff; bf16* XN2; float* SS;
    __device__ __forceinline__ void operator()(int row, int col, f32x4 v0, f32x4 v1) const {
        const size_t o = (size_t)row * 1024 + col; const f32x4 a = *(const f32x4*)(x + o) + v0, b = *(const f32x4*)(x + o + 4) + v1;
        *(f32x4*)(out + o) = a; *(f32x4*)(out + o + 4) = b;
        const f32x4 g0 = *(const f32x4*)(gff + col), g1 = *(const f32x4*)(gff + col + 4);
        *(v4u*)(XN2 + o) = pack8(a * g0, b * g1);
        float ss = (a.x * a.x + a.y * a.y) + (a.z * a.z + a.w * a.w) + (b.x * b.x + b.y * b.y) + (b.z * b.z + b.w * b.w);
        ss += __shfl_xor(ss, 16); ss += __shfl_xor(ss, 32);
        if ((threadIdx.x & 63) < 16) atomicAdd(SS + row, ss);
    }
};
struct OpZ {
    bf16* Z; const float* SS;
    __device__ __forceinline__ void operator()(int row, int col, f32x4 v0, f32x4 v1) const {
        const float rs = rsqf_(SS[row] * (1.f / D) + RMS_EPS);
        f32x4 a, b;
        a.x = fmaxf(v0.x, 0.f); a.y = fmaxf(v0.y, 0.f); a.z = fmaxf(v0.z, 0.f); a.w = fmaxf(v0.w, 0.f); b.x = fmaxf(v1.x, 0.f); b.y = fmaxf(v1.y, 0.f); b.z = fmaxf(v1.z, 0.f); b.w = fmaxf(v1.w, 0.f);
        a = a * rs; b = b * rs;
        *(v4u*)(Z + (size_t)row * FF + col) = pack8(a * a, b * b);
    }
};
struct OpAcc {
    float* out;
    __device__ __forceinline__ void operator()(int row, int col, f32x4 v0, f32x4 v1) const {
        float* o = out + (size_t)row * 1024 + col; const f32x4 a = *(const f32x4*)o, b = *(const f32x4*)(o + 4);
        *(f32x4*)o = a + v0; *(f32x4*)(o + 4) = b + v1;
    }
};
template <class Op, bool ALIGN>
__device__ __forceinline__ void run_gemm(LAS unsigned char* lds, const bf16* A, int lda, const bf16* Bt, int M, int N, int K, int ash, int amul, const Op& op) {
    pg8::Gemm g{A, Bt, M, N, K, lda, ash, amul}; pg8::StaticOrder S; S.init(M, N, (int)gridDim.x, (int)blockIdx.x);
    pg8::EpiOp<Op> E{op};
    pg8::gemm_phase<pg8::EpiOp<Op>, pg8::StaticOrder, ALIGN>(lds, g, S, E);
}

constexpr int CH = 32, REC = 336  , CHBYTES = CH * REC * 4;
__device__ __forceinline__ float dppf(float v, const int ctrl_sel) {
    const int x = __builtin_bit_cast(int, v); int r;
    if (ctrl_sel == 0) r = __builtin_amdgcn_update_dpp(0, x, 0xB1, 0xf, 0xf, true);
    else if (ctrl_sel == 1) r = __builtin_amdgcn_update_dpp(0, x, 0x4E, 0xf, 0xf, true);
    else if (ctrl_sel == 2) r = __builtin_amdgcn_update_dpp(0, x, 0x141, 0xf, 0xf, true);
    else r = __builtin_amdgcn_update_dpp(0, x, 0x140, 0xf, 0xf, true);
    return __builtin_bit_cast(float, r);
}
__device__ __forceinline__ float red16(float v) { v += dppf(v, 0); v += dppf(v, 1); v += dppf(v, 2); v += dppf(v, 3); return v; }

__device__ __forceinline__ float red32(float v) {
    v = red16(v); float a = v, b = v;
    asm volatile("s_nop 1\n\tv_permlane16_swap_b32 %0, %1" : "+v"(a), "+v"(b));
    return a + b;
}
struct ScanRegs { f32x4 a[5]; f32x4 v; };
__device__ __forceinline__ void scan_load(ScanRegs& R, const float* const* arr, const float* V, int mrow, int hcol, int vcol, int pt) {
    const int j = pt >> 4, q = pt & 15;
#pragma unroll
    for (int a = 0; a < 5; ++a) R.a[a] = *(const f32x4*)(arr[a] + (size_t)(mrow + j) * 1024 + hcol + 4 * q);
    R.v = *(const f32x4*)(V + (size_t)(mrow + ((pt & 63) >> 2)) * 1024 + vcol + 4 * (pt & 3));
}
__device__ __forceinline__ void scan_write(const ScanRegs& R, LAS unsigned char* buf, int pt) {
    const int j = pt >> 4, q = pt & 15;
#pragma unroll
    for (int a = 0; a < 5; ++a) *(LAS f32x4*)(buf + j * (REC * 4) + a * 256 + q * 16) = R.a[a];
    if (pt < 64) *(LAS f32x4*)(buf + (pt >> 2) * (REC * 4) + 1280 + (pt & 3) * 16) = R.v;
}

#define DECL_PTRS \
    GAS unsigned char* wsg_ = (GAS unsigned char*)p.ws; asm volatile("" : "+s"(wsg_)); unsigned char* ws = (unsigned char*)wsg_;     \
    float* SST = (float*)(ws + WS_SST); float* CHA = (float*)(ws + WS_CHA); float* CHBv = (float*)(ws + WS_CHB); float* CAR = (float*)(ws + WS_CAR); float* LST = (float*)(ws + WS_LST); float* CL = (float*)(ws + WS_CL); \
    bf16* Win_t = (bf16*)(ws + WS_WIN); bf16* Wpa_t = (bf16*)(ws + WS_WPA); bf16* Wpb_t = (bf16*)(ws + WS_WPB); bf16* Wout_t = (bf16*)(ws + WS_WOUT); bf16* Wup_t = (bf16*)(ws + WS_WUP); bf16* Wdn_t = (bf16*)(ws + WS_WDN); \
    bf16* Wlora_t = (bf16*)(ws + WS_WLORA); bf16* Wlru_t = (bf16*)(ws + WS_WLRU); \
    bf16* YA = (bf16*)(ws + WS_YA); bf16* YB = (bf16*)(ws + WS_YB); \
    bf16* XN = (bf16*)(ws + WS_XN); bf16* P = (bf16*)(ws + WS_P); bf16* HALO = (bf16*)(ws + WS_HALO); bf16* LA = (bf16*)(ws + WS_LA); bf16* XC = (bf16*)(ws + WS_XC); \
    bf16* L = (bf16*)(ws + WS_L); bf16* LRA = (bf16*)(ws + WS_LRA); bf16* LRB = (bf16*)(ws + WS_LRB); \
    float* SB = (float*)(ws + WS_R); bf16* Yr = (bf16*)(ws + WS_Y); \
    bf16* T1 = (bf16*)(ws + WS_T1); bf16* MIX = (bf16*)(ws + WS_MIX); bf16* XN2 = (bf16*)(ws + WS_XN2); bf16* Z = (bf16*)(ws + WS_Z); \
    bf16* GATES = (bf16*)p.out;

#define XB_TMO      128
#define XB_XCNT(j)  (256  + 64 * (j))
#define XB_XSUB(j)  (1280 + 64 * (j))
#define XB_XGEN(j)  (2304 + 64 * (j))
#define XB_TOP      3328
#define XB_TOPGEN   3392
#define XCD_BAR_WORDS 3456
#define XB_SPIN_CAP (1u << 18)

__device__ __forceinline__ unsigned xb_ld(unsigned* p)              { return __hip_atomic_load(p, __ATOMIC_RELAXED, __HIP_MEMORY_SCOPE_AGENT); }
__device__ __forceinline__ unsigned xb_add(unsigned* p, unsigned v) { return __hip_atomic_fetch_add(p, v, __ATOMIC_RELAXED, __HIP_MEMORY_SCOPE_AGENT); }
__device__ __forceinline__ unsigned xb_xcc_id() { return (unsigned)__builtin_amdgcn_s_getreg((3 << 11) | 20) & 0xFu; }
#define XB_SPIN(cond, bar) do { unsigned _sp = 0; while (cond) { __builtin_amdgcn_s_sleep(1); \
    if ((++_sp & 255u) == 0u) { if (xb_ld(&(bar)[XB_TMO])) break; if (_sp > XB_SPIN_CAP) { atomicAdd(&(bar)[XB_TMO], 1u); break; } } } } while (0)

struct XcdBarrier {
    unsigned* bar; unsigned x;
    volatile LAS unsigned* st;
};

__device__ __forceinline__ XcdBarrier xcd_barrier_post(unsigned* bar, volatile LAS unsigned* st) {
    XcdBarrier b; b.bar = bar; b.x = xb_xcc_id(); b.st = st;
    if (threadIdx.x == 0) (void)xb_add(&bar[XB_XCNT(b.x)], 1u);
    return b;
}
__device__ __forceinline__ void xcd_barrier_complete(unsigned* bar, unsigned x, unsigned& nloc, unsigned& nx) {
    const unsigned G = gridDim.x * gridDim.y * gridDim.z;
    unsigned sum, cnt, mine, sp = 0u;
    for (;;) {
        sum = 0u; cnt = 0u; mine = 0u;
#pragma unroll
        for (unsigned j = 0; j < 16; ++j) { const unsigned c = xb_ld(&bar[XB_XCNT(j)]); sum += c; cnt += (c > 0u) ? 1u : 0u; mine = (j == x) ? c : mine; }
        if (sum == G) break;
        __builtin_amdgcn_s_sleep(1);
        if ((++sp & 255u) == 0u) { if (xb_ld(&bar[XB_TMO])) break; if (sp > XB_SPIN_CAP) { atomicAdd(&bar[XB_TMO], 1u); break; } }
    }
    nloc = mine > 0u ? mine : 1u; nx = cnt > 0u ? cnt : 1u;
}

__device__ __forceinline__ void xcd_barrier(const XcdBarrier& b) {
    asm volatile("s_waitcnt vmcnt(0)" ::: "memory");
    __syncthreads();
    if (threadIdx.x == 0) {
        unsigned* bar = b.bar;
        __builtin_amdgcn_s_waitcnt(0);
        unsigned nloc = b.st[0], nx = b.st[1];
        if (nloc == 0u) { xcd_barrier_complete(bar, b.x, nloc, nx); b.st[0] = nloc; b.st[1] = nx; }
        const unsigned old = xb_add(&bar[XB_XSUB(b.x)], 1u);
        const unsigned gen = old / nloc;
        if (old + 1u == (gen + 1u) * nloc) {
            __builtin_amdgcn_fence(__ATOMIC_RELEASE, "agent");
            asm volatile("s_waitcnt vmcnt(0)" ::: "memory");
            const unsigned og = xb_add(&bar[XB_TOP], 1u);
            const unsigned tg = og / nx;
            if (og + 1u == (tg + 1u) * nx) xb_add(&bar[XB_TOPGEN], 1u);
            else XB_SPIN(xb_ld(&bar[XB_TOPGEN]) == tg, bar);
            __builtin_amdgcn_fence(__ATOMIC_ACQUIRE, "agent");
            xb_add(&bar[XB_XGEN(b.x)], 1u);
            asm volatile("s_waitcnt vmcnt(0)" ::: "memory");
        } else {
            XB_SPIN(xb_ld(&bar[XB_XGEN(b.x)]) == gen, bar);
            __builtin_amdgcn_fence(__ATOMIC_ACQUIRE, "agent");
            asm volatile("s_waitcnt vmcnt(0)" ::: "memory");
        }
    }
    __syncthreads();
}

#define LBAR() asm volatile("s_waitcnt lgkmcnt(0)\n\ts_barrier" ::: "memory")
#ifndef PROBE
#define PROBE 0
#endif
#define REP(k) for (int rep_ = 0; rep_ < ((PROBE == (k)) ? 2 : 1); ++rep_)
__global__ void __launch_bounds__(512, 2) fwd_megakernel(Params p) {
    extern __shared__ __attribute__((aligned(16))) unsigned char lds_raw[];
    cg::grid_group grid = cg::this_grid();
    LAS unsigned char* lds = (LAS unsigned char*)lds_raw;
    const int tid = threadIdx.x, lane = tid & 63, wave = __builtin_amdgcn_readfirstlane(tid >> 6);
    const int G = gridDim.x, bid = blockIdx.x, gw = bid * 8 + wave, NGW = G * 8, NGT = G * 512;
#define gtid (bid * 512 + opaque(tid))
    constexpr int HALO_PAR = NB * 3 * PC;

    REP(14) {
        DECL_PTRS
        LAS float* scr = (LAS float*)(lds + wave * 16384);
        const int lane = opaque(tid) & 63;
        constexpr int I_IN = (D / 64) * (NCOL / 32), I_SQ = (D / 64) * (D / 32), I_UP = (D / 64) * (FF / 32), I_DN = (FF / 64) * (D / 32);
        constexpr int NITEMS = I_IN + 3 * I_SQ + I_UP + I_DN;
        for (int it = gw; it < NITEMS; it += NGW) {
            int r = it;
            if (r < I_IN) { transpose_item(p.w_in, D, NCOL, Win_t, scr, r, lane); continue; } r -= I_IN;
            if (r < I_SQ) { transpose_item(p.w_proj_a, D, D, Wpa_t, scr, r, lane); continue; } r -= I_SQ;
            if (r < I_SQ) { transpose_item(p.w_proj_b, D, D, Wpb_t, scr, r, lane); continue; } r -= I_SQ;
            if (r < I_SQ) { transpose_item(p.w_out, D, D, Wout_t, scr, r, lane); continue; } r -= I_SQ;
            if (r < I_UP) { transpose_item(p.w_ff_up, D, FF, Wup_t, scr, r, lane); continue; } r -= I_UP;
            transpose_item(p.w_ff_down, FF, D, Wdn_t, scr, r, lane);
        }
        for (int e = gtid; e < 3072 * 128; e += NGT) {
            const int n = e >> 7, k = e & 127; float v;
            if (n < 1024) v = (k < 64) ? p.w_decay_up[k * 1024 + n] : 0.f;
            else if (n < 2048) v = (k >= 64) ? p.w_aaa_up[(k - 64) * 1024 + (n - 1024)] : 0.f;
            else v = p.w_gate_up[k * 1024 + (n - 2048)];
            Wlora_t[e] = (bf16)f2bf(v);
        }
        for (int e = gtid; e < 2048 * 128; e += NGT) {
            const int n = e >> 7, k = e & 127, pj = n >> 8, nn = n & 255, blk = nn >> 7, gate = (nn >> 6) & 1, j = nn & 63, kb = k >> 6, i = k & 63;
            const float* W = gate ? p.lru_wx : p.lru_wa;
            const float v = (kb == blk) ? W[((2 * pj + blk) * 64 + i) * 64 + j] : 0.f;
            Wlru_t[e] = (bf16)f2bf(v);
        }
        for (int e = gtid; e < HALO_PAR / 2; e += NGT) ((unsigned*)HALO)[e] = 0u;
        for (int e = gtid; e < 256 * 4 * 64 * 4; e += NGT) SST[e] = 0.f;
        for (int e = gtid; e < NB * 1024; e += NGT) LST[e] = 0.f;
        for (int e = gtid; e < 1024; e += NGT) CL[e] = -8.0f * log1pf(__expf(-p.lru_lambda[e]));
        for (int m = gw; m < NB * NMETA; m += NGW) rms_row_to_bf16(p.meta + (size_t)(m & 15) * D, p.norm_mix_g, XN + (size_t)m * D, opaque(tid) & 63);
        for (int e = gtid; e < XCD_BAR_WORDS; e += NGT) __hip_atomic_store((unsigned*)(ws + WS_BAR) + e, 0u, __ATOMIC_RELAXED, __HIP_MEMORY_SCOPE_AGENT);
        if (tid < 16) ((volatile LAS unsigned*)(lds + 131072))[tid] = 0u;
    }
    grid.sync();
    const XcdBarrier xbar = xcd_barrier_post((unsigned*)(p.ws + WS_BAR), (volatile LAS unsigned*)(lds + 131072) + 8);
#define GRID_SYNC() xcd_barrier(xbar)

    for (int s = 0; s < NSEG; ++s) {
        const int lgT = (s == 0) ? 4 : LGSEG, SEGT = 1 << lgT, Mseg = NB * SEGT, Mpad = (s == 0) ? 256 : MSEGMAX, gbase = (s == 0) ? 0 : (s - 1) * SEGMAX, nch = SEGT / CH;
        REP(5) { DECL_PTRS bf16* halo_next = HALO + (size_t)((s + 1) & 1) * HALO_PAR; OpP op{P, halo_next, GATES, Mseg, lgT, gbase, s}; run_gemm<OpP, true>(lds, XN, D, Win_t, Mpad, NCOL, D, 0, 0, op); }
        GRID_SYNC();
        REP(6) { DECL_PTRS const bf16* halo_cur = HALO + (size_t)(s & 1) * HALO_PAR;
        for (int m = gw; m < Mseg; m += NGW) {
            const int lane = opaque(tid) & 63;
            const int b = m >> lgT, i = m & (SEGT - 1);
            const bf16* cur = P + (size_t)m * PC;
            const bf16* pr1 = (i >= 1) ? cur - PC : halo_cur + (size_t)(b * 3 + 2) * PC;
            const bf16* pr2 = (i >= 2) ? cur - 2 * PC : halo_cur + (size_t)(b * 3 + 1 + i) * PC;
            const bf16* pr3 = (i >= 3) ? cur - 3 * PC : halo_cur + (size_t)(b * 3 + i) * PC;
            {
                const int c = 4 * lane; const v2u cw = *(const v2u*)(cur + OFF_WD + c), pw = *(const v2u*)(pr1 + OFF_WD + c); const f32x4 mu = *(const f32x4*)(p.mu + OFF_WD + c);
                float x0 = bflo(cw.x), x1 = bfhi(cw.x), x2 = bflo(cw.y), x3 = bfhi(cw.y);
                x0 += (bflo(pw.x) - x0) * mu.x; x1 += (bfhi(pw.x) - x1) * mu.y; x2 += (bflo(pw.y) - x2) * mu.z; x3 += (bfhi(pw.y) - x3) * mu.w;
                if (lane < 16) { x0 = tanhf_(x0); x1 = tanhf_(x1); x2 = tanhf_(x2); x3 = tanhf_(x3); }
                else if (lane >= 32) { x0 = sigmoidf_(x0); x1 = sigmoidf_(x1); x2 = sigmoidf_(x2); x3 = sigmoidf_(x3); }
                v2u o; o.x = pk2(x0, x1); o.y = pk2(x2, x3); *(v2u*)(LA + (size_t)m * 256 + c) = o;
            }
            {
                const int c = 16 * lane; float x0[16], x1[16], x2[16], x3[16], w[16], o[16];
                load16bf(pr3 + OFF_XB + c, x0); load16bf(pr2 + OFF_XB + c, x1); load16bf(pr1 + OFF_XB + c, x2); load16bf(cur + OFF_XB + c, x3);
                load16f(p.conv_b + c, o);
                load16f(p.conv_w + c, w);
#pragma unroll
                for (int j = 0; j < 16; ++j) o[j] += x0[j] * w[j];
                load16f(p.conv_w + 1024 + c, w);
#pragma unroll
                for (int j = 0; j < 16; ++j) o[j] += x1[j] * w[j];
                load16f(p.conv_w + 2048 + c, w);
#pragma unroll
                for (int j = 0; j < 16; ++j) o[j] += x2[j] * w[j];
                load16f(p.conv_w + 3072 + c, w);
#pragma unroll
                for (int j = 0; j < 16; ++j) o[j] += x3[j] * w[j];
                store16bf(XC + (size_t)m * 1024 + c, o);
            }
        } }
        GRID_SYNC();
        REP(7) { DECL_PTRS OpLora op{L, Mseg}; run_gemm<OpLora, true>(lds, LA, 256, Wlora_t, Mpad, 3072, 128, 3, 128, op); }
        REP(7) { DECL_PTRS OpLru op{LRA, LRB, XC, CL, p.lru_ba, p.lru_bx, Mseg}; run_gemm<OpLru, true>(lds, XC, 1024, Wlru_t, Mpad, 2048, 128, 0, 128, op); }
        GRID_SYNC();
        REP(3) { DECL_PTRS const bf16* halo_cur = HALO + (size_t)(s & 1) * HALO_PAR;
        const int lch = (SEGT < 32) ? SEGT : 32, nlc = SEGT / lch;
        const bool lru_bg = (s >= 1) && (G == 256) && (SEGT == 2048);
        if (!lru_bg)
        for (int idx = gtid; idx < NB * nlc * 512; idx += NGT) {
            const int c = 2 * (idx & 511), q = idx >> 9, chunk = q % nlc, b = q / nlc; const size_t m0 = (size_t)b * SEGT + chunk * lch;
            f32x2 ap = {1.f, 1.f}, bacc = {0.f, 0.f};
#pragma unroll 32
            for (int j = 0; j < lch; ++j) { const unsigned la_ = *(const unsigned*)(LRA + (m0 + j) * 1024 + c); const f32x2 a = {__expf(bflo(la_)), __expf(bfhi(la_))}; const unsigned lb = *(const unsigned*)(LRB + (m0 + j) * 1024 + c);
                const f32x2 bb = {sqrtf_(fmaxf(1.0f - a.x * a.x, 0.f)) * bflo(lb), sqrtf_(fmaxf(1.0f - a.y * a.y, 0.f)) * bfhi(lb)}; bacc = a * bacc + bb; ap = ap * a; }
            *(f32x2*)(CHA + (size_t)(b * 64 + chunk) * 1024 + c) = ap; *(f32x2*)(CHBv + (size_t)(b * 64 + chunk) * 1024 + c) = bacc;
        }
        const int nch = (SEGT + CH - 1) / CH;
        for (int u = bid; u < 256; u += G) {
            const int tq = opaque(tid), lane = tq & 63;
            const int bh = (u & 7) * 8 + ((u >> 3) >> 2), rg = (u >> 3) & 3, b = bh >> 4, h = bh & 15, mrow0 = b * SEGT, hcol = h * 64, vcol = hcol + rg * 16;
            __syncthreads();
            if (wave >= 4) {
                const int pt = tq - 256, pj = pt >> 4, pq = pt & 15, pc = hcol + 4 * pq;
                const f32x4 mu_r = *(const f32x4*)(p.mu + pc), mu_k = *(const f32x4*)(p.mu + 1024 + pc), mu_v = *(const f32x4*)(p.mu + 2048 + pc), c_w0 = *(const f32x4*)(p.w0 + pc), c_a0 = *(const f32x4*)(p.a0 + pc),
                            c_kk = *(const f32x4*)(p.k_k + pc), c_ka = *(const f32x4*)(p.k_a + pc), c_rk = *(const f32x4*)(p.r_k + pc);
                const bf16* halo_b = halo_cur + (size_t)(b * 3 + 2) * PC;
#define PREP_DECL(X) v2u X##rc, X##rp, X##kc, X##kp, X##vc, X##vp, X##ld, X##la
                PREP_DECL(A0); PREP_DECL(A1); PREP_DECL(B0); PREP_DECL(B1);
#define PREP_LOAD(X, cc, toff) { const int tj_ = (cc) * CH + pj + (toff); const bf16* cur_ = P + (size_t)(mrow0 + tj_) * PC; const bf16* prv_ = (tj_ >= 1) ? cur_ - PC : halo_b; \
                X##rc = *(const v2u*)(cur_ + pc); X##rp = *(const v2u*)(prv_ + pc); X##kc = *(const v2u*)(cur_ + 1024 + pc); X##kp = *(const v2u*)(prv_ + 1024 + pc); X##vc = *(const v2u*)(cur_ + 2048 + pc); X##vp = *(const v2u*)(prv_ + 2048 + pc); \
                const bf16* l_ = L + (size_t)(mrow0 + tj_) * 3072 + pc; X##ld = *(const v2u*)l_; X##la = *(const v2u*)(l_ + 1024); }
#define SHIFT4(C, Q, MU) ((f32x4){bflo(C.x) + (bflo(Q.x) - bflo(C.x)) * MU.x, bfhi(C.x) + (bfhi(Q.x) - bfhi(C.x)) * MU.y, bflo(C.y) + (bflo(Q.y) - bflo(C.y)) * MU.z, bfhi(C.y) + (bfhi(Q.y) - bfhi(C.y)) * MU.w})
#define PREP_CW(X, cc, bufp, toff) { const int tj_ = (cc) * CH + pj + (toff); LAS unsigned char* rec_ = (bufp) + (pj + (toff)) * (REC * 4); const bool ok_ = tj_ < SEGT; \
                const f32x4 r_ = SHIFT4(X##rc, X##rp, mu_r), k_ = SHIFT4(X##kc, X##kp, mu_k), v_ = SHIFT4(X##vc, X##vp, mu_v); \
                f32x4 w_, a_; w_.x = __expf(-0.6065306597126334f * sigmoidf_(c_w0.x + bflo(X##ld.x))); w_.y = __expf(-0.6065306597126334f * sigmoidf_(c_w0.y + bfhi(X##ld.x))); w_.z = __expf(-0.6065306597126334f * sigmoidf_(c_w0.z + bflo(X##ld.y))); w_.w = __expf(-0.6065306597126334f * sigmoidf_(c_w0.w + bfhi(X##ld.y))); \
                a_.x = sigmoidf_(c_a0.x + bflo(X##la.x)); a_.y = sigmoidf_(c_a0.y + bfhi(X##la.x)); a_.z = sigmoidf_(c_a0.z + bflo(X##la.y)); a_.w = sigmoidf_(c_a0.w + bfhi(X##la.y)); \
                f32x4 q_ = k_ * c_kk; const float ss_ = red16((q_.x * q_.x + q_.y * q_.y) + (q_.z * q_.z + q_.w * q_.w)); q_ = q_ * rsqf_(fmaxf(ss_, 1e-24f)); \
                f32x4 km_ = k_ * (1.0f + (a_ - 1.0f) * c_ka), bb_ = q_ * a_; \
                const f32x4 rk_ = r_ * km_ * c_rk; const float sb_ = red16((rk_.x + rk_.y) + (rk_.z + rk_.w)); \
                if (rg == 0 && pq == 0 && ok_) SB[(size_t)(mrow0 + tj_) * 16 + h] = sb_; \
                if (!ok_) { w_ = (f32x4){1.f, 1.f, 1.f, 1.f}; km_ = (f32x4){0.f, 0.f, 0.f, 0.f}; bb_ = km_; q_ = km_; }     \
                *(LAS f32x4*)(rec_ + pq * 16) = ok_ ? r_ : (f32x4){0.f, 0.f, 0.f, 0.f}; *(LAS f32x4*)(rec_ + 256 + pq * 16) = w_; *(LAS f32x4*)(rec_ + 512 + pq * 16) = km_; *(LAS f32x4*)(rec_ + 768 + pq * 16) = q_; *(LAS f32x4*)(rec_ + 1024 + pq * 16) = bb_; \
                if ((pq >> 2) == rg) *(LAS f32x4*)(rec_ + 1280 + (pq & 3) * 16) = ok_ ? v_ : (f32x4){0.f, 0.f, 0.f, 0.f}; }
#define CLAMPC(x) (((x) < nch) ? (x) : nch - 1)
                PREP_LOAD(A0, 0, 0); PREP_LOAD(A1, 0, 16); PREP_LOAD(B0, CLAMPC(1), 0); PREP_LOAD(B1, CLAMPC(1), 16);
                PREP_CW(A0, 0, lds, 0); PREP_CW(A1, 0, lds, 16); PREP_LOAD(A0, CLAMPC(2), 0); PREP_LOAD(A1, CLAMPC(2), 16);
                const float one_ = __builtin_bit_cast(float, opaque(0x3f800000)), zero_ = __builtin_bit_cast(float, opaque(0));
                f32x2 l_ap = {one_, one_}, l_b = {zero_, zero_};
                for (int c = 0; c < nch; c += 2) {
                    LBAR();
                    if (c + 1 < nch) { PREP_CW(B0, c + 1, lds + CHBYTES, 0); PREP_CW(B1, c + 1, lds + CHBYTES, 16); PREP_LOAD(B0, CLAMPC(c + 3), 0); PREP_LOAD(B1, CLAMPC(c + 3), 16); }
                    const bool dolru = lru_bg && (u == bid) && ((c & 7) == 4);
                    const int lsel = c >> 3, lidx = bid * 512 + pt + 256 * (lsel >> 2), lhb = lsel & 3;
                    const int lc = 2 * (lidx & 511), lq = lidx >> 9, lchunk = lq & 63, lb2 = lq >> 6; const size_t lm0 = (size_t)lb2 * SEGT + lchunk * 32 + lhb * 8;
                    unsigned la[8]; unsigned lbv[8];
                    if (dolru) {
#pragma unroll
                        for (int j = 0; j < 8; ++j) { la[j] = *(const unsigned*)(LRA + (lm0 + j) * 1024 + lc); lbv[j] = *(const unsigned*)(LRB + (lm0 + j) * 1024 + lc); }
                    } else {
#pragma unroll
                        for (int j = 0; j < 8; ++j) { la[j] = 0u; lbv[j] = 0u; }
                    }
                    if (c + 1 >= nch) break;
                    LBAR();
                    if (c + 2 < nch) { PREP_CW(A0, c + 2, lds, 0); PREP_CW(A1, c + 2, lds, 16); PREP_LOAD(A0, CLAMPC(c + 4), 0); PREP_LOAD(A1, CLAMPC(c + 4), 16); }
                    if (dolru) {
                        if (lhb == 0) { l_ap = (f32x2){one_, one_}; l_b = (f32x2){zero_, zero_}; }
#pragma unroll
                        for (int j = 0; j < 8; ++j) { const f32x2 a = {__expf(bflo(la[j])), __expf(bfhi(la[j]))}; const f32x2 bb = {sqrtf_(fmaxf(1.0f - a.x * a.x, 0.f)) * bflo(lbv[j]), sqrtf_(fmaxf(1.0f - a.y * a.y, 0.f)) * bfhi(lbv[j])}; l_b = a * l_b + bb; l_ap = l_ap * a; }
                        if (lhb == 3) { *(f32x2*)(CHA + (size_t)(lb2 * 64 + lchunk) * 1024 + lc) = l_ap; *(f32x2*)(CHBv + (size_t)(lb2 * 64 + lchunk) * 1024 + lc) = l_b; }
                    }
                }
#undef PREP_DECL
#undef PREP_LOAD
#undef PREP_CW
#undef SHIFT4
#undef CLAMPC
            } else {
                const int g4 = lane >> 4, kq = lane & 15;
                float* sst = SST + ((size_t)(u * 4 + wave) * 64 + lane) * 4;
                f32x2 S01, S23; { const f32x4 S = *(const f32x4*)sst; S01 = (f32x2){S.x, S.y}; S23 = (f32x2){S.z, S.w}; }
                const int ycol = vcol + wave * 4 + g4;
                const int lo = kq * 16, vo = 1280 + (wave * 4 + g4) * 4;
#define SC_DECL(X) f32x4 X##r, X##w, X##k, X##q, X##b; float X##v
#define SC_LD(X, j) { const LAS unsigned char* rec_ = buf + (j) * (REC * 4); X##r = *(const LAS f32x4*)(rec_ + lo); X##w = *(const LAS f32x4*)(rec_ + 256 + lo); X##k = *(const LAS f32x4*)(rec_ + 512 + lo); \
                      X##q = *(const LAS f32x4*)(rec_ + 768 + lo); X##b = *(const LAS f32x4*)(rec_ + 1024 + lo); X##v = *(const LAS float*)(rec_ + vo); }
#define SC_CP(X, Y) { X##r = Y##r; X##w = Y##w; X##k = Y##k; X##q = Y##q; X##b = Y##b; X##v = Y##v; }
#define LO2(v) ((f32x2){(v).x, (v).y})
#define HI2(v) ((f32x2){(v).z, (v).w})
#define SC_STEP(X, j) { f32x2 ta = S01 * LO2(X##q); ta = S23 * HI2(X##q) + ta; f32x2 tb = S01 * LO2(Pr); tb = S23 * HI2(Pr) + tb; \
                        float sa = ta.x + ta.y, yy = tb.x + tb.y; const f32x2 kv01 = LO2(X##k) * X##v, kv23 = HI2(X##k) * X##v; \
                        sa += dppf(sa, 0); yy += dppf(yy, 0); sa += dppf(sa, 1); yy += dppf(yy, 1); sa += dppf(sa, 2); yy += dppf(yy, 2); sa += dppf(sa, 3); yy += dppf(yy, 3); \
                        if ((j) > 0 && (j) <= 16) yk0 = (kq == (j) - 1) ? yy : yk0; if ((j) > 16) yk1 = (kq == (j) - 17) ? yy : yk1; \
                        S01 = S01 * LO2(X##w) + (kv01 - LO2(X##b) * sa); S23 = S23 * HI2(X##w) + (kv23 - HI2(X##b) * sa); Pr = X##r; }
                for (int c = 0; c < nch; ++c) {
                    LBAR();
                    const LAS unsigned char* buf = lds + (c & 1) * CHBYTES;
                    float yk0 = 0.f, yk1 = 0.f; f32x4 Pr;
                    SC_DECL(C0); SC_DECL(N0);
                    SC_LD(C0, 0);
                    SC_CP(N0, C0); Pr = C0r;
#pragma unroll
                    for (int j = 0; j < CH; ++j) {
                        if (j + 1 < CH) SC_LD(N0, j + 1);
                        SC_STEP(C0, j);
                        SC_CP(C0, N0);
                    }
                    { f32x2 tb = S01 * LO2(Pr); tb = S23 * HI2(Pr) + tb; const float yy = red16(tb.x + tb.y); yk1 = (kq == 15) ? yy : yk1; }
                    const int t0c = c * CH + kq;
                    if (t0c < SEGT) Yr[(size_t)(mrow0 + t0c) * 1024 + ycol] = (bf16)f2bf(yk0);
                    if (t0c + 16 < SEGT) Yr[(size_t)(mrow0 + t0c + 16) * 1024 + ycol] = (bf16)f2bf(yk1);
                }
#undef SC_DECL
#undef SC_LD
#undef SC_CP
#undef SC_STEP
#undef LO2
#undef HI2
                if (PROBE != 3 || rep_ == 1) *(f32x4*)sst = (f32x4){S01.x, S01.y, S23.x, S23.y};
            }
        } }
        GRID_SYNC();
        REP(4) { DECL_PTRS const bf16* halo_cur = HALO + (size_t)(s & 1) * HALO_PAR;
        if (s > 0) {
            for (int m = gw; m < Mseg; m += NGW) {
                const int lane = opaque(tid) & 63;
                const int b = m >> lgT, i = m & (SEGT - 1), c = 16 * lane; const size_t o = (size_t)m * 1024 + c;
                const bf16* cur = P + (size_t)m * PC; const bf16* pr1 = (i >= 1) ? cur - PC : halo_cur + (size_t)(b * 3 + 2) * PC;
                float y[16], t[16], u[16];
                load16bf(Yr + o, y); float sm = 0.f;
#pragma unroll
                for (int j = 0; j < 16; ++j) sm += y[j];
                const float mean = quad_sum(sm) * (1.f / 64.f); float vs = 0.f;
#pragma unroll
                for (int j = 0; j < 16; ++j) { y[j] -= mean; vs += y[j] * y[j]; }
                const float rstd = rsqf_(quad_sum(vs) * (1.f / 64.f) + LNX_EPS);
                load16f(p.ln_w + c, t); load16f(p.ln_b + c, u);
#pragma unroll
                for (int j = 0; j < 16; ++j) y[j] = y[j] * rstd * t[j] + u[j];
                const float bs = SB[(size_t)m * 16 + (lane >> 2)];
                shift16(cur + 2048 + c, pr1 + 2048 + c, p.mu + 2048 + c, t); load16bf(L + (size_t)m * 3072 + 2048 + c, u);
#pragma unroll
                for (int j = 0; j < 16; ++j) y[j] = (y[j] + bs * t[j]) * u[j];
                store16bf(YA + ((size_t)b * SEQ + gbase + i) * 1024 + c, y);
            }
        }
        {
            const int lch = (SEGT < 32) ? SEGT : 32, nlc = SEGT / lch;
            const float* LSTin = LST + (size_t)(s & 1) * (NB * 1024); float* LSTout = LST + (size_t)((s + 1) & 1) * (NB * 1024);
            for (int idx = gtid; idx < NB * nlc * 512; idx += NGT) {
                const int c = 2 * (idx & 511), q = idx >> 9, chunk = q % nlc, b = q / nlc; const size_t m0 = (size_t)b * SEGT + chunk * lch;
                f32x2 hh = *(const f32x2*)(LSTin + b * 1024 + c);
#pragma unroll 16
                for (int k = 0; k < chunk; ++k) { const size_t o = (size_t)(b * 64 + k) * 1024 + c; hh = *(const f32x2*)(CHA + o) * hh + *(const f32x2*)(CHBv + o); }
#pragma unroll 32
                for (int j = 0; j < lch; ++j) {
                    const unsigned la_ = *(const unsigned*)(LRA + (m0 + j) * 1024 + c); const f32x2 a = {__expf(bflo(la_)), __expf(bfhi(la_))}; const unsigned lb = *(const unsigned*)(LRB + (m0 + j) * 1024 + c);
                    const f32x2 bb = {sqrtf_(fmaxf(1.0f - a.x * a.x, 0.f)) * bflo(lb), sqrtf_(fmaxf(1.0f - a.y * a.y, 0.f)) * bfhi(lb)}; hh = a * hh + bb;
                    if (s > 0) { const unsigned yb = *(const unsigned*)(P + (m0 + j) * PC + OFF_YB + c);
                        *(unsigned*)(YB + ((size_t)b * SEQ + gbase + chunk * lch + j) * 1024 + c) = pk2(hh.x * gelu_tanh(bflo(yb)), hh.y * gelu_tanh(bfhi(yb))); }
                }
                if (chunk == nlc - 1 && (PROBE != 4 || rep_ == 1)) *(f32x2*)(LSTout + b * 1024 + c) = hh;
            }
        }
        if (s + 1 < NSEG) {
            for (int m = gw; m < MSEGMAX; m += 4 * NGW) {
                int mr[4]; const float* xr[4]; bf16* orow[4];
#pragma unroll
                for (int r = 0; r < 4; ++r) { mr[r] = (m + r * NGW < MSEGMAX) ? m + r * NGW : m; const int b = mr[r] >> LGSEG, i = mr[r] & (SEGMAX - 1); xr[r] = p.x + ((size_t)b * SEQ + (size_t)s * SEGMAX + i) * D; orow[r] = XN + (size_t)mr[r] * D; }
                rms_rows4_to_bf16(xr[0], xr[1], xr[2], xr[3], p.norm_mix_g, orow[0], orow[1], orow[2], orow[3], opaque(tid) & 63);
            }
        } }
        GRID_SYNC();
    }

    REP(10) { DECL_PTRS OpT1 op{T1, GATES}; run_gemm<OpT1, true>(lds, YA, D, Wpa_t, MT, D, D, 0, 0, op); }
    REP(10) { DECL_PTRS OpMix op{T1, GATES, MIX}; run_gemm<OpMix, true>(lds, YB, D, Wpb_t, MT, D, D, 0, 0, op); }
    { DECL_PTRS const int st_ = opaque(NGT); for (int e = gtid; e < MT; e += st_) CAR[e] = 0.f; }
    GRID_SYNC();
    REP(11) { DECL_PTRS OpH1 op{p.x, p.out, p.norm_ffn_g, XN2, CAR}; run_gemm<OpH1, true>(lds, MIX, D, Wout_t, MT, D, D, 0, 0, op); }
    GRID_SYNC();
    REP(13) { DECL_PTRS OpZ op{Z, CAR}; run_gemm<OpZ, true>(lds, XN2, D, Wup_t, MT, FF, D, 0, 0, op); }
    GRID_SYNC();
    { DECL_PTRS OpAcc op{p.out}; run_gemm<OpAcc, true>(lds, Z, FF, Wdn_t, MT, D, FF, 0, 0, op); }
    GRID_SYNC();
    for (int m = gw; m < MT; m += 4 * NGW) {
        const int lane = opaque(tid) & 63;
        float* rows[4]; f32x4 v[4][4];
#pragma unroll
        for (int r = 0; r < 4; ++r) { const int mr = (m + r * NGW < MT) ? m + r * NGW : m; rows[r] = p.out + (size_t)mr * D;
#pragma unroll
            for (int j = 0; j < 4; ++j) v[r][j] = *((const f32x4*)rows[r] + lane + 64 * j); }
        f32x4 gg[4];
#pragma unroll
        for (int j = 0; j < 4; ++j) gg[j] = *((const f32x4*)p.norm_final_g + lane + 64 * j);
#pragma unroll
        for (int r = 0; r < 4; ++r) {
            float sq = 0.f;
#pragma unroll
            for (int j = 0; j < 4; ++j) sq += (v[r][j].x * v[r][j].x + v[r][j].y * v[r][j].y) + (v[r][j].z * v[r][j].z + v[r][j].w * v[r][j].w);
            const float sc = rsqf_(wave_sum(sq) * (1.f / D) + RMS_EPS);
            if (r == 0 || m + r * NGW < MT) {
#pragma unroll
                for (int j = 0; j < 4; ++j) *((f32x4*)rows[r] + lane + 64 * j) = v[r][j] * sc * gg[j];
            }
        }
    }
    if (PROBE == 1) { for (int i = 0; i < 40; ++i) GRID_SYNC(); }
}

extern "C" void kernel_launch(void* const* d_in, const int* in_sizes, int n_in, void* d_out, int out_size, void* d_ws, size_t ws_size, hipStream_t stream) {
    static int grid_blocks = 0;
    if (grid_blocks == 0) {
        if (n_in != 29 || ws_size < WS_TAIL_END) { fprintf(stderr, "kernel_launch: unexpected n_in %d or ws_size %zu (< %zu)\n", n_in, ws_size, (size_t)WS_END); grid_blocks = -1; return; }
        int dev = 0, cus = 0, per_cu = 0;
        hipGetDevice(&dev);
        hipDeviceGetAttribute(&cus, hipDeviceAttributeMultiprocessorCount, dev);
        hipFuncSetAttribute((const void*)fwd_megakernel, hipFuncAttributeMaxDynamicSharedMemorySize, LDS_BYTES);
        hipOccupancyMaxActiveBlocksPerMultiprocessor(&per_cu, (const void*)fwd_megakernel, 512, LDS_BYTES);
        if (per_cu < 1) per_cu = 1;
        grid_blocks = cus * per_cu;
        (void)hipGetLastError();
    }
    if (grid_blocks < 0) return;
    Params p{};
    const float** f = (const float**)&p;
    for (int i = 0; i < 29; ++i) f[i] = (const float*)d_in[i];
    p.out = (float*)d_out; p.ws = (unsigned char*)d_ws;
    void* args[] = {&p};
    hipError_t e = hipLaunchCooperativeKernel((const void*)fwd_megakernel, dim3(grid_blocks), dim3(512), args, LDS_BYTES, stream);
    if (e != hipSuccess) fprintf(stderr, "cooperative launch failed: %s (grid %d)\n", hipGetErrorString(e), grid_blocks);
}
```
